# Optimizing an MI355X kernel written in HIP

```python
import math
import jax, jax.numpy as jnp
from jax import lax
import numpy as np

D_MODEL = 1024
BATCH = 8
SEQ = 2048
DEPTH = 1
DEC_BATCH = 128
DEC_SEQ = 4
PAST_LEN = 16384
PAGE_SIZE = 128

D_MIX = D_MODEL
GLA_HEADS = 4
GLA_DV = (D_MIX // 2) // GLA_HEADS
GLA_DK = GLA_DV // 2
GLA_KW = GLA_HEADS * GLA_DK
GLA_VW = GLA_HEADS * GLA_DV
GLA_GATE_RANK = 16
GLA_GATE_TAU = 16.0
SSD_INNER = D_MIX - GLA_VW
SSD_HEAD_DIM = 64
SSD_HEADS = SSD_INNER // SSD_HEAD_DIM
SSD_GROUPS = 2
SSD_STATE = 128
SSD_CONV = 4
SSD_CONV_CH = SSD_INNER + 2 * SSD_GROUPS * SSD_STATE
CHUNK = 64
MEM_LEN = 256
XA_HEADS = 4
XA_HEAD_DIM = D_MODEL // XA_HEADS
D_FF = -(-8 * D_MODEL // (3 * 256)) * 256
IN_SIZES = (GLA_KW, GLA_KW, GLA_VW, GLA_VW, GLA_GATE_RANK, SSD_INNER, SSD_CONV_CH, SSD_HEADS)
IN_COLS = sum(IN_SIZES)
EPS = 1e-6

kernel_name = 'hymba_gla_ssd_xmem_step'


def rmsnorm(x, w):
    xf = x.astype(jnp.float32)
    y = xf * lax.rsqrt(jnp.mean(xf * xf, axis=-1, keepdims=True) + EPS) * w.astype(jnp.float32)
    return y.astype(x.dtype)


def to_chunks(a, c):
    b, t = a.shape[:2]
    return jnp.swapaxes(a.reshape(b, t // c, c, *a.shape[2:]), 0, 1)


def from_chunks(a):
    nc, b, c = a.shape[:3]
    return jnp.swapaxes(a, 0, 1).reshape(b, nc * c, *a.shape[3:])


def gla_chunked(q, k, v, logf, s0):
    c = math.gcd(q.shape[1], CHUNK)
    causal = jnp.tril(jnp.ones((c, c), dtype=bool))

    def step(s, inp):
        qc, kc, vc, gc = inp
        b = jnp.cumsum(gc, axis=1)
        qt = qc * jnp.exp(b)
        kt = kc * jnp.exp(-b)
        att = jnp.where(causal, jnp.einsum('bthk,bshk->bhts', qt, kt), 0.0)
        o = jnp.einsum('bhts,bshv->bthv', att, vc) + jnp.einsum('bthk,bhkv->bthv', qt, s)
        bl = b[:, -1]
        s = jnp.exp(bl)[..., None] * s + jnp.einsum('bshk,bshv->bhkv', kc * jnp.exp(bl[:, None] - b), vc)
        return s, o

    s, o = lax.scan(step, s0, (to_chunks(q, c), to_chunks(k, c), to_chunks(v, c), to_chunks(logf, c)))
    return from_chunks(o), s


def ssd_chunked(x, dt, a_head, bh, ch, s0):
    c = math.gcd(x.shape[1], CHUNK)
    causal = jnp.tril(jnp.ones((c, c), dtype=bool))[None, :, :, None]

    def step(s, inp):
        xc, dtc, bc, cc = inp
        lc = jnp.cumsum(dtc * a_head, axis=1)
        seg = lc[:, :, None, :] - lc[:, None, :, :]
        decay = jnp.exp(jnp.where(causal, seg, -jnp.inf))
        cb = jnp.einsum('bthn,bshn->btsh', cc, bc)
        y = (jnp.einsum('btsh,bshp->bthp', cb * decay * dtc[:, None], xc)
             + jnp.einsum('bthn,bhpn->bthp', cc, s) * jnp.exp(lc)[..., None])
        ll = lc[:, -1]
        w = jnp.exp(ll[:, None] - lc) * dtc
        s = jnp.exp(ll)[:, :, None, None] * s + jnp.einsum('bsh,bshp,bshn->bhpn', w, xc, bc)
        return s, y

    s, y = lax.scan(step, s0, (to_chunks(x, c), to_chunks(dt, c), to_chunks(bh, c), to_chunks(ch, c)))
    return from_chunks(y), s


def mixer(hn, s_gla, s_ssm, conv_buf, lw):
    f32 = jnp.float32
    bsz, t, _ = hn.shape
    cuts = np.cumsum(IN_SIZES)[:-1].tolist()
    q, k, v, g, glr, z, xbc, dt_raw = jnp.split(hn @ lw['w_in'], cuts, axis=-1)
    q = q.reshape(bsz, t, GLA_HEADS, GLA_DK).astype(f32) * (GLA_DK ** -0.5)
    k = k.reshape(bsz, t, GLA_HEADS, GLA_DK).astype(f32)
    v = v.reshape(bsz, t, GLA_HEADS, GLA_DV).astype(f32)
    logf = jax.nn.log_sigmoid((glr @ lw['gla_gate_w2'] + lw['gla_gate_b']).astype(f32)) / GLA_GATE_TAU
    logf = logf.reshape(bsz, t, GLA_HEADS, GLA_DK)
    o, s_gla = gla_chunked(q, k, v, logf, s_gla.astype(f32))
    o = rmsnorm(o, lw['gla_norm_w']) * jax.nn.silu(g.reshape(bsz, t, GLA_HEADS, GLA_DV).astype(f32))
    o_gla = o.reshape(bsz, t, GLA_VW)
    full = jnp.concatenate([conv_buf.astype(xbc.dtype), xbc], axis=1)
    conv = lw['ssd_conv_b']
    for j in range(SSD_CONV):
        conv = conv + full[:, j:j + t] * lw['ssd_conv_w'][j]
    new_buf = full[:, full.shape[1] - (SSD_CONV - 1):]
    xbc_act = jax.nn.silu(conv.astype(f32))
    xs, bm, cm = jnp.split(xbc_act, [SSD_INNER, SSD_INNER + SSD_GROUPS * SSD_STATE], axis=-1)
    xs = xs.reshape(bsz, t, SSD_HEADS, SSD_HEAD_DIM)
    rep = SSD_HEADS // SSD_GROUPS
    bh = jnp.repeat(bm.reshape(bsz, t, SSD_GROUPS, SSD_STATE), rep, axis=2)
    chh = jnp.repeat(cm.reshape(bsz, t, SSD_GROUPS, SSD_STATE), rep, axis=2)
    dt = jax.nn.softplus((dt_raw + lw['ssd_dt_bias']).astype(f32))
    a_head = -jnp.exp(lw['ssd_A_log'].astype(f32))
    y, s_ssm = ssd_chunked(xs, dt, a_head, bh, chh, s_ssm.astype(f32))
    y = y + lw['ssd_D'].astype(f32)[:, None] * xs
    y = y.reshape(bsz, t, SSD_INNER) * jax.nn.silu(z.astype(f32))
    gs = SSD_INNER // SSD_GROUPS
    y = rmsnorm(y.reshape(bsz, t, SSD_GROUPS, gs), lw['ssd_norm_w'].reshape(SSD_GROUPS, gs)).reshape(bsz, t, SSD_INNER)
    mixed = jnp.concatenate([o_gla, y], axis=-1).astype(hn.dtype) @ lw['w_out']
    return mixed, s_gla, s_ssm, new_buf


def mem_kv(mem, mem_norm_w, w_xk, w_xv):
    b, m, _ = mem.shape
    mn = rmsnorm(mem, mem_norm_w)
    mk = (mn @ w_xk).reshape(b, m, XA_HEADS, XA_HEAD_DIM)
    mv = (mn @ w_xv).reshape(b, m, XA_HEADS, XA_HEAD_DIM)
    return mk, mv


def cross_attend(hn, mk, mv, w_xq, w_xo):
    b, t, _ = hn.shape
    q = (hn @ w_xq).reshape(b, t, XA_HEADS, XA_HEAD_DIM).astype(jnp.float32)
    s = jnp.einsum('bthd,bmhd->bhtm', q, mk.astype(jnp.float32)) * (XA_HEAD_DIM ** -0.5)
    p = jax.nn.softmax(s, axis=-1)
    o = jnp.einsum('bhtm,bmhd->bthd', p, mv.astype(jnp.float32)).reshape(b, t, D_MODEL)
    return o.astype(hn.dtype) @ w_xo


def decoder_layer(x, s_gla, s_ssm, conv_buf, mk, mv, lw):
    m, s_gla, s_ssm, conv_buf = mixer(rmsnorm(x, lw['ln_mix_pre']), s_gla, s_ssm, conv_buf, lw)
    h = x + rmsnorm(m, lw['ln_mix_post'])
    a = cross_attend(rmsnorm(h, lw['ln_xa_pre']), mk, mv, lw['w_xq'], lw['w_xo'])
    h = h + rmsnorm(a, lw['ln_xa_post'])
    hf = rmsnorm(h, lw['ln_ffn_pre'])
    f = (jax.nn.silu(hf @ lw['w_gate']) * (hf @ lw['w_up'])) @ lw['w_down']
    h = h + rmsnorm(f, lw['ln_ffn_post'])
    return h, s_gla, s_ssm, conv_buf


def setup_inputs(seed: int = 0) -> dict:
    key = jax.random.key(seed)
    ks = iter(jax.random.split(key, 48))

    def nrm(shape, scale):
        return jax.random.normal(next(ks), shape, jnp.float32) * scale

    def gain(n):
        return 1.0 + nrm((DEPTH, n), 0.02)

    L = DEPTH
    dt0 = jnp.exp(jax.random.uniform(next(ks), (L, SSD_HEADS), jnp.float32,
                                     math.log(1e-3), math.log(1e-1)))
    dt_bias = dt0 + jnp.log(-jnp.expm1(-dt0))
    a_log = jnp.log(jax.random.uniform(next(ks), (L, SSD_HEADS), jnp.float32, 1.0, 16.0))
    return {
        'x_prompt': nrm((BATCH, SEQ, D_MODEL), 1.0),
        'x_sample': nrm((DEC_BATCH, DEC_SEQ, D_MODEL), 1.0),
        'mem_prompt': nrm((BATCH, MEM_LEN, D_MODEL), 1.0),
        'state_gla': nrm((L, DEC_BATCH, GLA_HEADS, GLA_DK, GLA_DV), 0.1),
        'state_ssm': nrm((L, DEC_BATCH, SSD_HEADS, SSD_HEAD_DIM, SSD_STATE), 0.1),
        'state_conv': nrm((L, DEC_BATCH, SSD_CONV - 1, SSD_CONV_CH), 1.0),
        'cache_mem_k': nrm((L, DEC_BATCH, MEM_LEN, XA_HEADS, XA_HEAD_DIM), 1.0),
        'cache_mem_v': nrm((L, DEC_BATCH, MEM_LEN, XA_HEADS, XA_HEAD_DIM), 1.0),
        'ln_mix_pre': gain(D_MODEL),
        'ln_mix_post': gain(D_MODEL),
        'w_in': nrm((L, D_MODEL, IN_COLS), D_MODEL ** -0.5),
        'gla_gate_w2': nrm((L, GLA_GATE_RANK, GLA_KW), GLA_GATE_RANK ** -0.5),
        'gla_gate_b': nrm((L, GLA_KW), 0.1),
        'gla_norm_w': gain(GLA_DV),
        'ssd_conv_w': nrm((L, SSD_CONV, SSD_CONV_CH), SSD_CONV ** -0.5),
        'ssd_conv_b': nrm((L, SSD_CONV_CH), 0.02),
        'ssd_dt_bias': dt_bias,
        'ssd_A_log': a_log,
        'ssd_D': 1.0 + nrm((L, SSD_HEADS), 0.1),
        'ssd_norm_w': gain(SSD_INNER),
        'w_out': nrm((L, D_MIX, D_MODEL), D_MIX ** -0.5),
        'ln_xa_pre': gain(D_MODEL),
        'ln_xa_post': gain(D_MODEL),
        'mem_norm_w': gain(D_MODEL),
        'w_xq': nrm((L, D_MODEL, D_MODEL), D_MODEL ** -0.5),
        'w_xk': nrm((L, D_MODEL, D_MODEL), D_MODEL ** -0.5),
        'w_xv': nrm((L, D_MODEL, D_MODEL), D_MODEL ** -0.5),
        'w_xo': nrm((L, D_MODEL, D_MODEL), D_MODEL ** -0.5),
        'ln_ffn_pre': gain(D_MODEL),
        'ln_ffn_post': gain(D_MODEL),
        'w_gate': nrm((L, D_MODEL, D_FF), D_MODEL ** -0.5),
        'w_up': nrm((L, D_MODEL, D_FF), D_MODEL ** -0.5),
        'w_down': nrm((L, D_FF, D_MODEL), D_FF ** -0.5),
    }


def reference(x_prompt, x_sample, mem_prompt, state_gla, state_ssm, state_conv, cache_mem_k, cache_mem_v,
              ln_mix_pre, ln_mix_post, w_in, gla_gate_w2, gla_gate_b, gla_norm_w, ssd_conv_w, ssd_conv_b,
              ssd_dt_bias, ssd_A_log, ssd_D, ssd_norm_w, w_out, ln_xa_pre, ln_xa_post, mem_norm_w,
              w_xq, w_xk, w_xv, w_xo, ln_ffn_pre, ln_ffn_post, w_gate, w_up, w_down):
    bp = x_prompt.shape[0]
    hp, hs = x_prompt, x_sample
    gla_p, ssm_p, conv_p, mk_p, mv_p = [], [], [], [], []
    gla_s, ssm_s, conv_s = [], [], []
    for l in range(DEPTH):
        lw = dict(ln_mix_pre=ln_mix_pre[l], ln_mix_post=ln_mix_post[l], w_in=w_in[l],
                  gla_gate_w2=gla_gate_w2[l], gla_gate_b=gla_gate_b[l], gla_norm_w=gla_norm_w[l],
                  ssd_conv_w=ssd_conv_w[l], ssd_conv_b=ssd_conv_b[l], ssd_dt_bias=ssd_dt_bias[l],
                  ssd_A_log=ssd_A_log[l], ssd_D=ssd_D[l], ssd_norm_w=ssd_norm_w[l], w_out=w_out[l],
                  ln_xa_pre=ln_xa_pre[l], ln_xa_post=ln_xa_post[l], w_xq=w_xq[l], w_xo=w_xo[l],
                  ln_ffn_pre=ln_ffn_pre[l], ln_ffn_post=ln_ffn_post[l],
                  w_gate=w_gate[l], w_up=w_up[l], w_down=w_down[l])
        mk, mv = mem_kv(mem_prompt, mem_norm_w[l], w_xk[l], w_xv[l])
        s0_gla = jnp.zeros((bp, GLA_HEADS, GLA_DK, GLA_DV), jnp.float32)
        s0_ssm = jnp.zeros((bp, SSD_HEADS, SSD_HEAD_DIM, SSD_STATE), jnp.float32)
        c0 = jnp.zeros((bp, SSD_CONV - 1, SSD_CONV_CH), x_prompt.dtype)
        hp, sg, ss, cb = decoder_layer(hp, s0_gla, s0_ssm, c0, mk, mv, lw)
        gla_p.append(sg.astype(state_gla.dtype))
        ssm_p.append(ss.astype(state_ssm.dtype))
        conv_p.append(cb.astype(state_conv.dtype))
        mk_p.append(mk.astype(cache_mem_k.dtype))
        mv_p.append(mv.astype(cache_mem_v.dtype))
        hs, sg, ss, cb = decoder_layer(hs, state_gla[l], state_ssm[l], state_conv[l],
                                       cache_mem_k[l], cache_mem_v[l], lw)
        gla_s.append(sg.astype(state_gla.dtype))
        ssm_s.append(ss.astype(state_ssm.dtype))
        conv_s.append(cb.astype(state_conv.dtype))
    return (hp, hs, jnp.stack(gla_p), jnp.stack(ssm_p), jnp.stack(conv_p), jnp.stack(mk_p), jnp.stack(mv_p),
            jnp.stack(gla_s), jnp.stack(ssm_s), jnp.stack(conv_s))
```

```cpp
#include <hip/hip_runtime.h>
#include <hip/hip_cooperative_groups.h>
#include <cstdio>
namespace cg = cooperative_groups;

#define DI __device__ __forceinline__
#define LAS __attribute__((address_space(3)))
typedef unsigned short bf16_t;
typedef short bf16x8 __attribute__((ext_vector_type(8)));
typedef short s16x4 __attribute__((ext_vector_type(4)));
typedef float f32x2 __attribute__((ext_vector_type(2)));
typedef float f32x4 __attribute__((ext_vector_type(4)));
typedef float f32x16 __attribute__((ext_vector_type(16)));
typedef unsigned u32x2 __attribute__((ext_vector_type(2)));
typedef unsigned u32x4 __attribute__((ext_vector_type(4)));
typedef __bf16 bf16x2v __attribute__((ext_vector_type(2)));
typedef LAS unsigned char* ldsp;

DI unsigned pk2(float lo, float hi) { f32x2 v = {lo, hi}; return __builtin_bit_cast(unsigned, __builtin_convertvector(v, bf16x2v)); }
DI bf16_t f2bf(float x) { return (bf16_t)(pk2(x, 0.f) & 0xffffu); }
DI float bf2f(bf16_t b) { return __uint_as_float(((unsigned)b) << 16); }
DI float bflo(unsigned u) { return __uint_as_float(u << 16); }
DI float bfhi(unsigned u) { return __uint_as_float(u & 0xffff0000u); }
DI float siluf(float x) { return x * __builtin_amdgcn_rcpf(1.f + __expf(-x)); }
DI void lbar() { asm volatile("s_waitcnt lgkmcnt(0)" ::: "memory"); __builtin_amdgcn_s_barrier(); asm volatile("" ::: "memory"); }
DI float softplusf(float x) { return fmaxf(x, 0.f) + __logf(1.f + __expf(-fabsf(x))); }
DI f32x4 unpk4(u32x2 u) { return (f32x4){bflo(u.x), bfhi(u.x), bflo(u.y), bfhi(u.y)}; }
DI u32x2 pk4(f32x4 v) { u32x2 w; w.x = pk2(v[0], v[1]); w.y = pk2(v[2], v[3]); return w; }
#define RCOL(e) (((e) >> 1) * 512 + lane * 8 + ((e) & 1) * 4)
DI u32x4 pk8(f32x4 a, f32x4 b) { u32x4 w; w.x = pk2(a[0], a[1]); w.y = pk2(a[2], a[3]); w.z = pk2(b[0], b[1]); w.w = pk2(b[2], b[3]); return w; }
DI void ld_row_bf16(const bf16_t* rowp, f32x4 (&v)[4], int lane) {
#pragma unroll
  for (int i = 0; i < 2; ++i) { const u32x4 u = *(const u32x4*)(rowp + i * 512 + lane * 8);
    v[2 * i] = (f32x4){bflo(u.x), bfhi(u.x), bflo(u.y), bfhi(u.y)}; v[2 * i + 1] = (f32x4){bflo(u.z), bfhi(u.z), bflo(u.w), bfhi(u.w)}; }
}
DI void ld_row_f32(const float* rowp, f32x4 (&v)[4], int lane) {
#pragma unroll
  for (int e = 0; e < 4; ++e) v[e] = *(const f32x4*)(rowp + RCOL(e));
}
DI float wave_sum(float v) { for (int o = 32; o >= 1; o >>= 1) v += __shfl_xor(v, o); return v; }

constexpr int D = 1024, TP = 16384, TS = 512, T = TP + TS, NIN = 3096, NINP = 3328, DFF = 2816;
constexpr int C_Q = 0, C_K = 256, C_V = 512, C_G = 1024, C_GLR = 1536, C_Z = 1552, C_XBC = 2064, C_DT = 3088;
constexpr float EPS = 1e-6f;
constexpr size_t O_Y = 0, O_GLAP = 17301504, O_SSMP = 17563648, O_CONVP = 18087936, O_MK = 18112512, O_MV = 20209664,
                 O_GLAS = 22306816, O_SSMS = 26501120, O_CONVS = 34889728;
constexpr size_t W_IN = 0, W_KV = W_IN + (size_t)NINP * D * 2, W_OUT = W_KV + 2048ull * D * 2, W_XQ = W_OUT + (size_t)D * D * 2, W_XO = W_XQ + (size_t)D * D * 2,
                 W_GU = W_XO + (size_t)D * D * 2, W_DN = W_GU + 5632ull * D * 2, B_XA = W_DN + (size_t)D * DFF * 2, B_MN = B_XA + (size_t)T * D * 2,
                 B_PROJ = B_MN + 2048ull * D * 2, B_MKB = B_PROJ + (size_t)T * NINP * 2, B_MVT = B_MKB + 2048ull * D * 2, B_GOUT = B_MVT + 2048ull * D * 2,
                 B_QX = B_GOUT + (size_t)T * D * 4, B_QT = B_QX + (size_t)T * D * 2, B_KT = B_QT + (size_t)T * 256 * 2, B_KD = B_KT + (size_t)T * 256 * 2,
                 B_XACT = B_KD + (size_t)T * 256 * 2, B_EB = B_XACT + (size_t)T * D * 2, B_DT = B_EB + 384ull * 256 * 4, B_LC = B_DT + (size_t)T * 8 * 4, B_PART = B_LC + (size_t)T * 8 * 4, B_H = B_PART + 11ull * 512 * 1024 * 4, WS_END = B_H + (size_t)T * D * 2;

struct Params {
  const float* in[33];
  float* out;
  unsigned char* ws;
};

constexpr int LDS_BYTES = 147456;

DI bf16x8 ldfrag(ldsp base, int ld, int row0, int k0, int lane) {
  return *(const LAS bf16x8*)(base + (row0 + (lane & 15)) * ld + (k0 + 8 * (lane >> 4)) * 2);
}
DI bf16x8 ldfrag_tr(ldsp base, int ld, int k0, int n0, int lane) {
  const int g = lane >> 4, q = (lane & 15) >> 2, pp = lane & 3;
  ldsp a = base + (k0 + 8 * g + q) * ld + (n0 + 4 * pp) * 2;
  s16x4 lo = __builtin_amdgcn_ds_read_tr16_b64_v4i16((LAS s16x4*)a);
  s16x4 hi = __builtin_amdgcn_ds_read_tr16_b64_v4i16((LAS s16x4*)(a + 4 * ld));
  return __builtin_shufflevector(lo, hi, 0, 1, 2, 3, 4, 5, 6, 7);
}
DI f32x4 mma16(bf16x8 bfrag, bf16x8 afrag, f32x4 acc) { return __builtin_amdgcn_mfma_f32_16x16x32_bf16(bfrag, afrag, acc, 0, 0, 0); }

namespace pg8 {
constexpr int BM = 256, BK = 64, HALF = 128, HTB = HALF * BK * 2, STAGE_BYTES = 8 * HTB, NXCD = 8, WGM = 8;
DI int lds_byte(int r, int c) { const int st = (r >> 4) * 2 + (c >> 5), rr = r & 15, cc = c & 31, ob = rr * 64 + cc * 2; return st * 1024 + (ob ^ (((ob >> 9) & 1) << 5)); }
DI void stage_rc(int b, int& R, int& C) { const int st = b / 1024, sb = b % 1024, swz = sb ^ (((sb >> 9) & 1) << 5); R = (st >> 1) * 16 + swz / 64; C = (st & 1) * 32 + (swz % 64) / 2; }
struct Unit { int pm, pn, g, kp; };
DI void map_unit(int L, int nM, int nN, int& pm, int& pn) {
  const int nwg = nM * nN; int wgid = L;
  { const int q = nwg / NXCD, r = nwg % NXCD, xcd = wgid % NXCD, off = wgid / NXCD; wgid = (xcd < r ? xcd * (q + 1) : r * (q + 1) + (xcd - r) * q) + off; }
  const int nig = WGM * nN, gid = wgid / nig, fm = gid * WGM, gsz = (nM - fm) < WGM ? (nM - fm) : WGM;
  pm = fm + ((wgid % nig) % gsz); pn = (wgid % nig) / gsz;
}
struct Sched {
  const bf16_t* A0; const bf16_t* B0; int nM0, nN0; const bf16_t* A1; const bf16_t* B1; int nM1, nN1; int G, c, K; int tM, KP;
  DI bool next(int i, Unit& u) const {
    int L = i * G + c; const int n0 = nM0 * nN0, n1 = nM1 * nN1; u.kp = 0;
    const int p1 = (n1 > 0 && n1 <= G && n0 + n1 > G) ? G - n1 : n0;
    if (L >= p1 && L < p1 + n1) { u.g = 1; map_unit(L - p1, nM1, nN1, u.pm, u.pn); return true; }
    if (L >= p1 + n1) L -= n1;
    if (L < n0) { u.g = 0; map_unit(L, nM0, nN0, u.pm, u.pn); return true; }
    L -= n0; if (L < tM * nN0 * KP) { u.g = 2; u.kp = L % KP; const int tile = L / KP; u.pm = nM0 + tile / nN0; u.pn = tile % nN0; return true; }
    return false;
  }
  DI int nt(const Unit& u) const { return u.g == 2 ? K / KP / BK : K / BK; }
  DI const char* aptr(const Unit& u) const { return (const char*)(u.g == 1 ? A1 : A0) + (size_t)u.pm * 512 * K + (u.g == 2 ? (size_t)u.kp * (K / KP) * 2 : 0); }
  DI const char* bptr(const Unit& u) const { return (const char*)(u.g == 1 ? B1 : B0) + (size_t)u.pn * 512 * K + (u.g == 2 ? (size_t)u.kp * (K / KP) * 2 : 0); }
};

template <class Epi>
DI void gemm_phase(ldsp lds, const Sched& S, const Epi& E) {
  int tid = threadIdx.x; asm volatile("" : "+v"(tid));
  const int wid = __builtin_amdgcn_readfirstlane(tid >> 6), lane = tid & 63, wr = wid >> 2, wc = wid & 3, fr = lane & 15, fq = lane >> 4;
  const int K = S.K;
  unsigned voffA[2], voffB[2];
#pragma unroll
  for (int i = 0; i < 2; ++i) { int R, C; stage_rc(tid * 16 + i * 8192, R, C); voffA[i] = (unsigned)(R * K + C) * 2u;
    const int rho = R & 31, Rb = (R & ~31) + 8 * ((rho & 15) >> 2) + 4 * (rho >> 4) + (rho & 3); voffB[i] = (unsigned)(Rb * K + C) * 2u; }
  const size_t kstep = (size_t)(BK * 2);
  const size_t hstep = (size_t)HALF * K * 2;
  const unsigned ldsw = (unsigned)wid * 1024u;
  const int aoff = lds_byte(wr * 64 + fr, fq * 8), boff = lds_byte(wc * 32 + fr, fq * 8);
#define PG8_SA(b, h) (((b) * 2 + (h)) * HTB)
#define PG8_SB(b, h) ((4 + (b) * 2 + (h)) * HTB)
#define PG8_STAGE(bufoff, gbase, voff) do { _Pragma("unroll") for (int _i = 0; _i < 2; ++_i) \
        __builtin_amdgcn_global_load_lds((const unsigned*)((const char*)(gbase) + (voff)[_i]), (LAS unsigned*)(lds + (bufoff) + ldsw + _i * 8192), 16, 0, 0); } while (0)
#define PG8_LDA(dst, b, h) do { _Pragma("unroll") for (int m = 0; m < 4; ++m) _Pragma("unroll") for (int k = 0; k < 2; ++k) dst[m][k] = *(const LAS bf16x8*)(lds + PG8_SA(b, h) + aoff + m * 2048 + k * 1024); } while (0)
#define PG8_LDB(dst, b, h) do { _Pragma("unroll") for (int n = 0; n < 2; ++n) _Pragma("unroll") for (int k = 0; k < 2; ++k) dst[n][k] = *(const LAS bf16x8*)(lds + PG8_SB(b, h) + boff + n * 2048 + k * 1024); } while (0)
#define PG8_MMA(ai, bj, At, Bt) do { __builtin_amdgcn_s_setprio(1); _Pragma("unroll") for (int m = 0; m < 4; ++m) _Pragma("unroll") for (int n = 0; n < 2; ++n) _Pragma("unroll") for (int k = 0; k < 2; ++k) \
        acc[ai][bj][m][n] = __builtin_amdgcn_mfma_f32_16x16x32_bf16(Bt[n][k], At[m][k], acc[ai][bj][m][n], 0, 0, 0); __builtin_amdgcn_s_setprio(0); } while (0)
#define PG8_WAIT_V(n) asm volatile("s_waitcnt vmcnt(" #n ")" ::: "memory")
#define PG8_WAIT_L(n) asm volatile("s_waitcnt lgkmcnt(" #n ")" ::: "memory")
#define PG8_BAR __builtin_amdgcn_s_barrier()
#define PG8_SCHED __builtin_amdgcn_sched_barrier(0)
  Unit cur, nxt; int ui = 0;
  if (!S.next(0, cur)) return;
  f32x4 acc[2][2][4][2];
#pragma unroll
  for (int a = 0; a < 2; ++a)
#pragma unroll
    for (int b = 0; b < 2; ++b)
#pragma unroll
      for (int m = 0; m < 4; ++m)
#pragma unroll
        for (int n = 0; n < 2; ++n) acc[a][b][m][n] = (f32x4){0.f, 0.f, 0.f, 0.f};
  bf16x8 At[4][2], B0[2][2], B1[2][2];
  const char* cA = S.aptr(cur); const char* cB = S.bptr(cur);
  PG8_STAGE(PG8_SB(0, 0), cB, voffB); PG8_STAGE(PG8_SA(0, 0), cA, voffA); PG8_STAGE(PG8_SB(0, 1), cB + hstep, voffB); PG8_STAGE(PG8_SA(0, 1), cA + hstep, voffA);
  if (wr == 1) PG8_BAR;
  PG8_WAIT_V(4); PG8_BAR;
  PG8_STAGE(PG8_SB(1, 0), cB + kstep, voffB); PG8_STAGE(PG8_SA(1, 0), cA + kstep, voffA); PG8_STAGE(PG8_SB(1, 1), cB + hstep + kstep, voffB);
  PG8_WAIT_V(6); PG8_BAR;
  for (;;) {
    const bool has_next = S.next(ui + 1, nxt);
    const char* nA = has_next ? S.aptr(nxt) : cA; const char* nB = has_next ? S.bptr(nxt) : cB;
    const int nt = S.nt(cur);
    for (int t = 0; t < nt; t += 2) {
      const bool last = (t == nt - 2);
      const char* a1 = cA + (size_t)(t + 1) * kstep;
      const char* a2 = last ? nA : cA + (size_t)(t + 2) * kstep; const char* b2 = last ? nB : cB + (size_t)(t + 2) * kstep;
      const char* a3 = a2 + kstep; const char* b3 = b2 + kstep;
      PG8_LDB(B0, 0, 0); PG8_SCHED; PG8_LDA(At, 0, 0); PG8_STAGE(PG8_SA(1, 1), a1 + hstep, voffA);
      PG8_WAIT_L(8); PG8_BAR; PG8_WAIT_L(0); PG8_MMA(0, 0, At, B0); PG8_BAR; PG8_SCHED;
      PG8_LDB(B1, 0, 1); PG8_STAGE(PG8_SB(0, 0), b2, voffB);
      PG8_BAR; PG8_WAIT_L(0); PG8_MMA(0, 1, At, B1); PG8_BAR;
      PG8_LDA(At, 0, 1); PG8_STAGE(PG8_SA(0, 0), a2, voffA);
      PG8_BAR; PG8_WAIT_L(0); PG8_MMA(1, 0, At, B0); PG8_BAR; PG8_SCHED;
      PG8_STAGE(PG8_SB(0, 1), b2 + hstep, voffB);
      PG8_WAIT_V(6); PG8_BAR; PG8_MMA(1, 1, At, B1); PG8_BAR;
      PG8_LDB(B0, 1, 0); PG8_SCHED; PG8_LDA(At, 1, 0); PG8_STAGE(PG8_SA(0, 1), a2 + hstep, voffA);
      PG8_WAIT_L(8); PG8_BAR; PG8_WAIT_L(0); PG8_MMA(0, 0, At, B0); PG8_BAR; PG8_SCHED;
      PG8_LDB(B1, 1, 1); PG8_STAGE(PG8_SB(1, 0), b3, voffB);
      PG8_BAR; PG8_WAIT_L(0); PG8_MMA(0, 1, At, B1); PG8_BAR;
      PG8_LDA(At, 1, 1); PG8_STAGE(PG8_SA(1, 0), a3, voffA);
      PG8_BAR; PG8_WAIT_L(0); PG8_MMA(1, 0, At, B0); PG8_BAR; PG8_SCHED;
      PG8_STAGE(PG8_SB(1, 1), b3 + hstep, voffB);
      PG8_WAIT_V(6); PG8_BAR; PG8_MMA(1, 1, At, B1); PG8_BAR;
    }
    E(acc, cur, wr, wc, fr, fq);
    if (!has_next) break;
#pragma unroll
    for (int a = 0; a < 2; ++a)
#pragma unroll
      for (int b = 0; b < 2; ++b)
#pragma unroll
        for (int m = 0; m < 4; ++m)
#pragma unroll
          for (int n = 0; n < 2; ++n) acc[a][b][m][n] = (f32x4){0.f, 0.f, 0.f, 0.f};
    cur = nxt; cA = nA; cB = nB; ++ui;
  }
  PG8_WAIT_V(0);
  if (wr == 0) PG8_BAR;
  PG8_BAR;
#undef PG8_SA
#undef PG8_SB
#undef PG8_STAGE
#undef PG8_LDA
#undef PG8_LDB
#undef PG8_MMA
#undef PG8_WAIT_V
#undef PG8_WAIT_L
#undef PG8_BAR
#undef PG8_SCHED
}

#define EPI_LOOP(...) \
  _Pragma("unroll") for (int ai = 0; ai < 2; ++ai) _Pragma("unroll") for (int m = 0; m < 4; ++m) { const int row = u.pm * 256 + ai * 128 + wr * 64 + m * 16 + fr; \
    _Pragma("unroll") for (int bj = 0; bj < 2; ++bj) { const int col = u.pn * 256 + bj * 128 + wc * 32 + 8 * fq; const f32x4 v0 = acc[ai][bj][m][0], v1 = acc[ai][bj][m][1]; __VA_ARGS__ } }

struct EpiF32 {
  bf16_t* C; int ldc; float* part;
  DI void operator()(const f32x4 (&acc)[2][2][4][2], const Unit& u, int wr, int wc, int fr, int fq) const {
    if (u.g == 2) { EPI_LOOP({ float* d = part + ((size_t)u.kp * 512 + (row - TP)) * 1024 + col; *(f32x4*)d = v0; *(f32x4*)(d + 4) = v1; }) }
    else { EPI_LOOP({ *(u32x4*)(C + (size_t)row * ldc + col) = pk8(v0, v1); }) }
  }
};
struct EpiBf16 {
  bf16_t* O; int ldc; float scale; float* part;
  DI void operator()(const f32x4 (&acc)[2][2][4][2], const Unit& u, int wr, int wc, int fr, int fq) const {
    if (u.g == 2) { EPI_LOOP({ float* d = part + ((size_t)u.kp * 512 + (row - TP)) * 1024 + col; *(f32x4*)d = v0; *(f32x4*)(d + 4) = v1; }) }
    else { EPI_LOOP({ *(u32x4*)(O + (size_t)row * ldc + col) = pk8(v0 * scale, v1 * scale); }) }
  }
};
struct EpiP1 {
  bf16_t* proj; float* mk; float* mv; bf16_t* mkb; bf16_t* mvt;
  DI void operator()(const f32x4 (&acc)[2][2][4][2], const Unit& u, int wr, int wc, int fr, int fq) const {
    if (u.g == 0) {
      EPI_LOOP({ *(u32x4*)(proj + (size_t)row * NINP + col) = pk8(v0, v1); })
    } else if (u.pn < 4) {
      EPI_LOOP({ float* d = mk + (size_t)row * D + col; *(f32x4*)d = v0; *(f32x4*)(d + 4) = v1; *(u32x4*)(mkb + (size_t)row * D + col) = pk8(v0, v1); })
    } else {
      EPI_LOOP({ const int c2 = col - 1024; float* d = mv + (size_t)row * D + c2; *(f32x4*)d = v0; *(f32x4*)(d + 4) = v1;
                 const int b = row >> 8, key = row & 255, hh = c2 >> 8, dd = c2 & 255;
                 bf16_t* dst = mvt + ((size_t)((b * 4 + hh) * 256 + dd)) * 256 + key;
                 dst[0] = f2bf(v0[0]); dst[256] = f2bf(v0[1]); dst[512] = f2bf(v0[2]); dst[768] = f2bf(v0[3]);
                 dst[1024] = f2bf(v1[0]); dst[1280] = f2bf(v1[1]); dst[1536] = f2bf(v1[2]); dst[1792] = f2bf(v1[3]); })
    }
  }
};
struct EpiGU {
  bf16_t* act;
  DI void operator()(const f32x4 (&acc)[2][2][4][2], const Unit& u, int wr, int wc, int fr, int fq) const {
#pragma unroll
    for (int ai = 0; ai < 2; ++ai)
#pragma unroll
      for (int m = 0; m < 4; ++m) { const int row = u.pm * 256 + ai * 128 + wr * 64 + m * 16 + fr, col = u.pn * 128 + wc * 32 + 8 * fq;
        f32x4 o0, o1;
#pragma unroll
        for (int j = 0; j < 4; ++j) { o0[j] = siluf(acc[ai][0][m][0][j]) * acc[ai][1][m][0][j]; o1[j] = siluf(acc[ai][0][m][1][j]) * acc[ai][1][m][1][j]; }
        *(u32x4*)(act + (size_t)row * DFF + col) = pk8(o0, o1); }
  }
};
}

DI const float* prep_row_src(const Params& p, int r) { return r < TP ? p.in[0] + (size_t)r * D : (r < T ? p.in[1] + (size_t)(r - TP) * D : p.in[2] + (size_t)(r - T) * D); }
DI void rownorm_store(const f32x4 (&v)[4], const float* w, bf16_t* o, int lane) {
  float ss = 0.f;
#pragma unroll
  for (int e = 0; e < 4; ++e) ss += v[e][0] * v[e][0] + v[e][1] * v[e][1] + v[e][2] * v[e][2] + v[e][3] * v[e][3];
  ss = wave_sum(ss); const float rstd = rsqrtf(ss * (1.f / 1024.f) + EPS);
#pragma unroll
  for (int i = 0; i < 2; ++i) { const f32x4 w0 = *(const f32x4*)(w + RCOL(2 * i)), w1 = *(const f32x4*)(w + RCOL(2 * i + 1));
    *(u32x4*)(o + i * 512 + lane * 8) = pk8(v[2 * i] * rstd * w0, v[2 * i + 1] * rstd * w1); }
}
DI void tr_weight(const float* W, bf16_t* Wt, const int K, const int N, const int ntn, const int drow_off, const int gu, const int rot, ldsp lds, int tid, const int G, const int lb) {
  LAS float* tile = (LAS float*)lds;
  const int nn = tid & 63, kb = tid >> 6, n2 = tid >> 3, kq = tid & 7;
  const int ktiles = K / 64, ntiles = ntn * ktiles;
  int task = (lb + G - (rot % G)) % G;
  float pre[8];
  if (task < ntiles) { const int n = (task / ktiles) * 64 + nn, k0 = (task % ktiles) * 64;
#pragma unroll
    for (int i = 0; i < 8; ++i) pre[i] = (n < N) ? W[(size_t)(k0 + kb + 8 * i) * N + n] : 0.f; }
  while (task < ntiles) {
#pragma unroll
    for (int i = 0; i < 8; ++i) tile[(kb + 8 * i) * 65 + nn] = pre[i];
    const int n0 = (task / ktiles) * 64, k0 = (task % ktiles) * 64;
    const int nxt = task + G;
    if (nxt < ntiles) { const int n = (nxt / ktiles) * 64 + nn, k1 = (nxt % ktiles) * 64;
#pragma unroll
      for (int i = 0; i < 8; ++i) pre[i] = (n < N) ? W[(size_t)(k1 + kb + 8 * i) * N + n] : 0.f; }
    lbar();
    float v[8];
#pragma unroll
    for (int j = 0; j < 8; ++j) v[j] = tile[(kq * 8 + j) * 65 + n2];
    u32x4 w; w.x = pk2(v[0], v[1]); w.y = pk2(v[2], v[3]); w.z = pk2(v[4], v[5]); w.w = pk2(v[6], v[7]);
    const int drow0 = gu ? (n0 >> 7) * 256 + (gu - 1) * 128 + (n0 & 127) : n0 + drow_off;
    *(u32x4*)(Wt + (size_t)(drow0 + n2) * K + k0 + kq * 8) = w;
    lbar();
    task = nxt;
  }
}
DI void phase_prep(const Params& p, ldsp lds, int tid_) {
  int tid = tid_; asm volatile("" : "+v"(tid));
  const int G = gridDim.x, wid = tid >> 6, lane = tid & 63;
  unsigned char* ws = p.ws;
  tr_weight(p.in[10], (bf16_t*)(ws + W_IN), 1024, NIN, 52, 0, 0, 0, lds, tid, G, (int)blockIdx.x);
  tr_weight(p.in[25], (bf16_t*)(ws + W_KV), 1024, 1024, 16, 0, 0, 832, lds, tid, G, (int)blockIdx.x);
  tr_weight(p.in[26], (bf16_t*)(ws + W_KV), 1024, 1024, 16, 1024, 0, 1088, lds, tid, G, (int)blockIdx.x);
  {
    const int wv = blockIdx.x * 8 + wid, nwv = G * 8, NR = T + 2048;
    f32x4 v0[4], v1[4];
    const int r1 = wv + nwv;
    if (wv < NR) {
#pragma unroll
      for (int i = 0; i < 4; ++i) v0[i] = *(const f32x4*)(prep_row_src(p, wv) + RCOL(i)); }
    if (r1 < NR) {
#pragma unroll
      for (int i = 0; i < 4; ++i) v1[i] = *(const f32x4*)(prep_row_src(p, r1) + RCOL(i)); }
    for (int r = wv; r < NR; r += nwv) {
      const int rn = r + 2 * nwv; f32x4 v2[4];
      const int rc = rn < NR ? rn : r;
#pragma unroll
      for (int i = 0; i < 4; ++i) v2[i] = *(const f32x4*)(prep_row_src(p, rc) + RCOL(i));
      if (r < T) rownorm_store(v0, p.in[8], (bf16_t*)(ws + B_XA) + (size_t)r * D, lane);
      else rownorm_store(v0, p.in[23], (bf16_t*)(ws + B_MN) + (size_t)(r - T) * D, lane);
#pragma unroll
      for (int i = 0; i < 4; ++i) { v0[i] = v1[i]; v1[i] = v2[i]; }
    }
  }
}

DI u32x4 ld16(const bf16_t* p) { return *(const u32x4*)p; }
#define Z4 ((u32x4){0u, 0u, 0u, 0u})

DI void precompute_item(const Params& p, int item, ldsp lds, int tid_) {
  int tid = tid_; asm volatile("" : "+v"(tid));
  const int wid = __builtin_amdgcn_readfirstlane(tid >> 6), lane = tid & 63;
  const bf16_t* proj = (const bf16_t*)(p.ws + B_PROJ);
  const bool sample = item >= 256;
  const int bs = item - 256, c = item & 31;
  const int r0 = sample ? TP + bs * 4 : (item >> 5) * 2048 + c * 64, ntok = sample ? 4 : 64;
  ldsp W2L = lds, GL = lds + 16384, QR = lds + 20480, KR = lds + 53248, BT = lds + 86016;
#pragma unroll
  for (int i = 0; i < 4; ++i) { const int idx = tid + 512 * i, t = idx >> 5, pc = idx & 31; const bool ok = t < ntok; const bf16_t* sp = proj + (size_t)(r0 + t) * NINP + pc * 8;
    *(LAS u32x4*)(QR + t * 512 + pc * 16) = ok ? ld16(sp + C_Q) : Z4; *(LAS u32x4*)(KR + t * 512 + pc * 16) = ok ? ld16(sp + C_K) : Z4; }
  if (tid < 128) { const int t2 = tid >> 1, p2 = tid & 1; const u32x4 rg = (t2 < ntok) ? ld16(proj + (size_t)(r0 + t2) * NINP + C_GLR + p2 * 8) : Z4;
    *(LAS f32x4*)(GL + (t2 * 16 + p2 * 8) * 4) = (f32x4){bflo(rg.x), bfhi(rg.x), bflo(rg.y), bfhi(rg.y)}; *(LAS f32x4*)(GL + (t2 * 16 + p2 * 8 + 4) * 4) = (f32x4){bflo(rg.z), bfhi(rg.z), bflo(rg.w), bfhi(rg.w)}; }
  {
    const int ch = 2 * tid;
    float cw[4][2], cb[2];
#pragma unroll
    for (int j = 0; j < 4; ++j) { const f32x2 w = *(const f32x2*)(p.in[14] + j * 1024 + ch); cw[j][0] = w[0]; cw[j][1] = w[1]; }
    { const f32x2 w = *(const f32x2*)(p.in[15] + ch); cb[0] = w[0]; cb[1] = w[1]; }
    unsigned x0 = 0u, x1 = 0u, x2 = 0u;
    if (sample) { const float* sp = p.in[5] + (size_t)bs * 3072 + ch; const f32x2 a0 = *(const f32x2*)sp, a1 = *(const f32x2*)(sp + 1024), a2 = *(const f32x2*)(sp + 2048);
      x0 = pk2(a0[0], a0[1]); x1 = pk2(a1[0], a1[1]); x2 = pk2(a2[0], a2[1]); }
    else if (c > 0) { const bf16_t* sp = proj + (size_t)(r0 - 3) * NINP + C_XBC + ch; x0 = *(const unsigned*)sp; x1 = *(const unsigned*)(sp + NINP); x2 = *(const unsigned*)(sp + 2 * NINP); }
    unsigned* xact = (unsigned*)((bf16_t*)(p.ws + B_XACT) + (size_t)r0 * D + ch);
    const int nb = sample ? 1 : 4;
#pragma unroll 1
    for (int tb = 0; tb < nb; ++tb) {
      unsigned xr[16];
#pragma unroll
      for (int i = 0; i < 16; ++i) { const int t = tb * 16 + i; xr[i] = (t < ntok) ? *(const unsigned*)(proj + (size_t)(r0 + t) * NINP + C_XBC + ch) : 0u; }
#pragma unroll
      for (int i = 0; i < 16; ++i) { const int t = tb * 16 + i; const unsigned x3 = xr[i];
        const float a0 = cb[0] + cw[0][0] * bflo(x0) + cw[1][0] * bflo(x1) + cw[2][0] * bflo(x2) + cw[3][0] * bflo(x3);
        const float a1 = cb[1] + cw[0][1] * bfhi(x0) + cw[1][1] * bfhi(x1) + cw[2][1] * bfhi(x2) + cw[3][1] * bfhi(x3);
        if (t < ntok) xact[(size_t)t * (D / 2)] = pk2(siluf(a0), siluf(a1));
        x0 = x1; x1 = x2; x2 = x3; }
    }
  }
  { const float dtb = p.in[16][wid], aneg = -__expf(p.in[17][wid]);
    const float raw = (lane < ntok) ? bf2f(proj[(size_t)(r0 + lane) * NINP + C_DT + wid]) : 0.f;
    const float dtv = (lane < ntok) ? softplusf(raw + dtb) : 0.f;
    float x = dtv * aneg;
#pragma unroll
    for (int o = 1; o < 64; o <<= 1) { const float y = __shfl_up(x, o); if (lane >= o) x += y; }
    if (lane < ntok) { ((float*)(p.ws + B_DT))[(size_t)(r0 + lane) * 8 + wid] = dtv; ((float*)(p.ws + B_LC))[(size_t)(r0 + lane) * 8 + wid] = x; } }
  __syncthreads();
  float pre[4][8];
#pragma unroll
  for (int hh = 0; hh < 4; ++hh) { const int col = hh * 64 + lane; float w2[16];
#pragma unroll
    for (int r = 0; r < 16; ++r) w2[r] = *(const LAS float*)(W2L + (r * 256 + col) * 4);
    const float gbias = p.in[12][col]; float run = 0.f;
#pragma unroll
    for (int i = 0; i < 8; ++i) { const int t = wid * 8 + i; float x = gbias;
#pragma unroll
      for (int r4 = 0; r4 < 4; ++r4) { const f32x4 gv = *(const LAS f32x4*)(GL + (t * 16 + r4 * 4) * 4); x += gv[0] * w2[r4 * 4] + gv[1] * w2[r4 * 4 + 1] + gv[2] * w2[r4 * 4 + 2] + gv[3] * w2[r4 * 4 + 3]; }
      const float lf = (t < ntok) ? -softplusf(-x) * (1.f / 16.f) : 0.f; run += lf; pre[hh][i] = run; }
    *(LAS float*)(BT + (wid * 256 + col) * 4) = run; }
  __syncthreads();
  bf16_t* qtg = (bf16_t*)(p.ws + B_QT); bf16_t* ktg = (bf16_t*)(p.ws + B_KT);
#pragma unroll
  for (int hh = 0; hh < 4; ++hh) { const int col = hh * 64 + lane; float off = 0.f, tot = 0.f;
#pragma unroll
    for (int j = 0; j < 8; ++j) { const float v = *(const LAS float*)(BT + (j * 256 + col) * 4); tot += v; if (j < wid) off += v; }
#pragma unroll
    for (int i = 0; i < 8; ++i) { const int t = wid * 8 + i; const float bi = off + pre[hh][i];
      const float q = bf2f(*(const LAS bf16_t*)(QR + t * 512 + col * 2)), k = bf2f(*(const LAS bf16_t*)(KR + t * 512 + col * 2));
      if (t < ntok) { const size_t o = (size_t)(r0 + t) * 256 + col;
        qtg[o] = f2bf(q * 0.125f * __expf(bi)); ktg[o] = f2bf(k * __expf(-bi)); } }
    if (wid == 0) ((float*)(p.ws + B_EB))[(size_t)item * 256 + col] = __expf(tot); }
  __syncthreads();
}
DI void phase_precompute(const Params& p, ldsp lds, int tid) {
  for (int i = tid; i < 4096; i += 512) *(LAS float*)(lds + i * 4) = p.in[11][i];
  __syncthreads();
  for (int item = blockIdx.x; item < 384; item += gridDim.x) precompute_item(p, item, lds, tid);
}

DI void gla_chain(const Params& p, int b, int h, bool sample, ldsp lds, int tid_) {
  int tid = tid_; asm volatile("" : "+v"(tid));
  const int wid = __builtin_amdgcn_readfirstlane(tid >> 6), lane = tid & 63, fr = lane & 15, fq = lane >> 4;
  const bf16_t* proj = (const bf16_t*)(p.ws + B_PROJ);
  const bf16_t* qtg = (const bf16_t*)(p.ws + B_QT); const bf16_t* ktg = (const bf16_t*)(p.ws + B_KT);
  const float* ebg = (const float*)(p.ws + B_EB);
  bf16_t* oraw = (bf16_t*)(p.ws + B_GOUT);
  const int nchunks = sample ? 1 : 32, ntok = sample ? 4 : 64, rowbase = sample ? TP + b * 4 : b * 2048, item0 = sample ? 256 + b : b * 32;
  ldsp VV = lds, QT = lds + 17408, KT = lds + 26624, KD = lds + 35840, ATT = lds + 45056, SB = lds + 54272, EB = lds + 71680;
  f32x4 Sacc[4];
  float* sout = p.out + (sample ? O_GLAS : O_GLAP) + (size_t)(b * 4 + h) * 8192;
#pragma unroll
  for (int kt = 0; kt < 4; ++kt) {
    if (sample) Sacc[kt] = *(const f32x4*)(p.in[3] + (size_t)(b * 4 + h) * 8192 + (kt * 16 + fr) * 128 + wid * 16 + 4 * fq);
    else Sacc[kt] = (f32x4){0.f, 0.f, 0.f, 0.f};
    u32x2 w; w.x = pk2(Sacc[kt][0], Sacc[kt][1]); w.y = pk2(Sacc[kt][2], Sacc[kt][3]);
    *(LAS u32x2*)(SB + (kt * 16 + fr) * 272 + (wid * 16 + 4 * fq) * 2) = w;
  }
  u32x4 rq = Z4, rk = Z4, rv0 = Z4, rv1 = Z4; float reb = 0.f;
  const int tq_ = tid >> 3, pq_ = tid & 7;
#define GLA_LOAD(c) do { const int r0 = rowbase + (c) * 64; \
    { const bool ok = tq_ < ntok; const size_t o = (size_t)(r0 + tq_) * 256 + h * 64 + pq_ * 8; rq = ok ? ld16(qtg + o) : Z4; rk = ok ? ld16(ktg + o) : Z4; } \
    { const int t0 = tid >> 4, p0 = tid & 15; rv0 = (t0 < ntok) ? ld16(proj + (size_t)(r0 + t0) * NINP + C_V + h * 128 + p0 * 8) : Z4; \
      const int t1 = (tid + 512) >> 4; rv1 = (t1 < ntok) ? ld16(proj + (size_t)(r0 + t1) * NINP + C_V + h * 128 + p0 * 8) : Z4; } \
    if (tid < 64) reb = ebg[(size_t)(item0 + (c)) * 256 + h * 64 + tid]; } while (0)
  GLA_LOAD(0);
  for (int c = 0; c < nchunks; ++c) {
    *(LAS u32x4*)(QT + tq_ * 144 + pq_ * 16) = rq; *(LAS u32x4*)(KT + tq_ * 144 + pq_ * 16) = rk;
    *(LAS u32x4*)(VV + (tid >> 4) * 272 + (tid & 15) * 16) = rv0; *(LAS u32x4*)(VV + ((tid + 512) >> 4) * 272 + (tid & 15) * 16) = rv1;
    if (tid < 64) *(LAS float*)(EB + tid * 4) = reb;
    if (c + 1 < nchunks) GLA_LOAD(c + 1);
    lbar();
    f32x4 oacc[4];
    { const int tt = wid >> 1;
#pragma unroll
      for (int u = 0; u < 2; ++u) { const int st = (wid & 1) * 2 + u; f32x4 a = {0.f, 0.f, 0.f, 0.f};
        if (st <= tt) {
#pragma unroll
          for (int ks = 0; ks < 2; ++ks) a = mma16(ldfrag(KT, 144, st * 16, ks * 32, lane), ldfrag(QT, 144, tt * 16, ks * 32, lane), a);
          const int t = tt * 16 + fr, s0 = st * 16 + 4 * fq;
#pragma unroll
          for (int j = 0; j < 4; ++j) if (s0 + j > t) a[j] = 0.f;
        }
        u32x2 w; w.x = pk2(a[0], a[1]); w.y = pk2(a[2], a[3]);
        *(LAS u32x2*)(ATT + (tt * 16 + fr) * 144 + (st * 16 + 4 * fq) * 2) = w; }
      bf16x8 sf[2];
#pragma unroll
      for (int ks = 0; ks < 2; ++ks) sf[ks] = ldfrag_tr(SB, 272, ks * 32, wid * 16, lane);
#pragma unroll
      for (int t4 = 0; t4 < 4; ++t4) { oacc[t4] = (f32x4){0.f, 0.f, 0.f, 0.f};
#pragma unroll
        for (int ks = 0; ks < 2; ++ks) oacc[t4] = mma16(sf[ks], ldfrag(QT, 144, t4 * 16, ks * 32, lane), oacc[t4]); } }
    lbar();
    { bf16x8 vf[2];
#pragma unroll
      for (int ks = 0; ks < 2; ++ks) vf[ks] = ldfrag_tr(VV, 272, ks * 32, wid * 16, lane);
#pragma unroll
      for (int t4 = 0; t4 < 4; ++t4) {
#pragma unroll
        for (int ks = 0; ks < 2; ++ks) if (ks * 2 <= t4) oacc[t4] = mma16(vf[ks], ldfrag(ATT, 144, t4 * 16, ks * 32, lane), oacc[t4]);
        const int t = t4 * 16 + fr;
        if (t < ntok) *(u32x2*)(oraw + (size_t)(rowbase + c * 64 + t) * D + h * 128 + wid * 16 + 4 * fq) = pk4(oacc[t4]); }
#pragma unroll
      for (int kt = 0; kt < 4; ++kt) { const float eb = *(const LAS float*)(EB + (kt * 16 + fr) * 4);
#pragma unroll
        for (int ks = 0; ks < 2; ++ks) Sacc[kt] = mma16(vf[ks], ldfrag_tr(KT, 144, ks * 32, kt * 16, lane), Sacc[kt]);
        Sacc[kt] *= eb;
        u32x2 w; w.x = pk2(Sacc[kt][0], Sacc[kt][1]); w.y = pk2(Sacc[kt][2], Sacc[kt][3]);
        *(LAS u32x2*)(SB + (kt * 16 + fr) * 272 + (wid * 16 + 4 * fq) * 2) = w; } }
    lbar();
  }
#undef GLA_LOAD
#pragma unroll
  for (int kt = 0; kt < 4; ++kt) *(f32x4*)(sout + (kt * 16 + fr) * 128 + wid * 16 + 4 * fq) = Sacc[kt];
}

DI void ssd_step(ldsp lds, int c, int wid, int lane, int tid, int ntok, int rowbase, int h, float Dh, bf16_t* oraw, f32x4 (&Sacc)[4]) {
  const int fr = lane & 15, fq = lane >> 4;
  ldsp MM = lds, XW = lds + 9216, SB = lds + 18432;
  ldsp IB = lds + 35840 + (c & 1) * 53248;
  ldsp XS = IB, ZR = IB + 9216, BMI = IB + 17408, CMI = IB + 34816, DTs = IB + 52224, LC = IB + 52480;
  const float ll = *(const LAS float*)(LC + 63 * 4);
  f32x4 y2[2];
  { const int tt = wid >> 1;
    const float lct = *(const LAS float*)(LC + (tt * 16 + fr) * 4);
    bf16x8 cf[4];
#pragma unroll
    for (int ks = 0; ks < 4; ++ks) cf[ks] = ldfrag(CMI, 272, tt * 16, ks * 32, lane);
    { const int s = tid >> 3, p0 = (tid & 7) * 8; const float wgt = __expf(ll - *(const LAS float*)(LC + s * 4)) * *(const LAS float*)(DTs + s * 4);
      const u32x4 xv = *(const LAS u32x4*)(XS + s * 144 + p0 * 2); u32x4 o;
      o.x = pk2(bflo(xv.x) * wgt, bfhi(xv.x) * wgt); o.y = pk2(bflo(xv.y) * wgt, bfhi(xv.y) * wgt); o.z = pk2(bflo(xv.z) * wgt, bfhi(xv.z) * wgt); o.w = pk2(bflo(xv.w) * wgt, bfhi(xv.w) * wgt);
      *(LAS u32x4*)(XW + s * 144 + p0 * 2) = o; }
#pragma unroll
    for (int u = 0; u < 2; ++u) { const int st = (wid & 1) * 2 + u; f32x4 a = {0.f, 0.f, 0.f, 0.f};
      if (st <= tt) {
#pragma unroll
        for (int ks = 0; ks < 4; ++ks) a = mma16(ldfrag(BMI, 272, st * 16, ks * 32, lane), cf[ks], a);
        const int t = tt * 16 + fr, s0 = st * 16 + 4 * fq;
        const f32x4 lcs = *(const LAS f32x4*)(LC + s0 * 4), dts = *(const LAS f32x4*)(DTs + s0 * 4);
#pragma unroll
        for (int j = 0; j < 4; ++j) a[j] = (s0 + j <= t) ? a[j] * __expf(lct - lcs[j]) * dts[j] : 0.f;
      }
      u32x2 w; w.x = pk2(a[0], a[1]); w.y = pk2(a[2], a[3]);
      *(LAS u32x2*)(MM + (tt * 16 + fr) * 144 + (st * 16 + 4 * fq) * 2) = w; }
#pragma unroll
    for (int u = 0; u < 2; ++u) { const int pt = (wid & 1) * 2 + u; y2[u] = (f32x4){0.f, 0.f, 0.f, 0.f};
#pragma unroll
      for (int ks = 0; ks < 4; ++ks) y2[u] = mma16(ldfrag(SB, 272, pt * 16, ks * 32, lane), cf[ks], y2[u]); } }
  lbar();
  { const int tt = wid >> 1, t = tt * 16 + fr;
    const float elc = __expf(*(const LAS float*)(LC + t * 4));
    bf16x8 mf[2];
#pragma unroll
    for (int ks = 0; ks < 2; ++ks) mf[ks] = ldfrag(MM, 144, tt * 16, ks * 32, lane);
#pragma unroll
    for (int u = 0; u < 2; ++u) { const int pt = (wid & 1) * 2 + u; f32x4 y1 = {0.f, 0.f, 0.f, 0.f};
#pragma unroll
      for (int ks = 0; ks < 2; ++ks) if (ks * 2 <= tt) y1 = mma16(ldfrag_tr(XS, 144, ks * 32, pt * 16, lane), mf[ks], y1);
      const int p0 = pt * 16 + 4 * fq;
      const u32x2 xv = *(const LAS u32x2*)(XS + t * 144 + p0 * 2), zv = *(const LAS u32x2*)(ZR + t * 128 + p0 * 2);
      const float xs4[4] = {bflo(xv.x), bfhi(xv.x), bflo(xv.y), bfhi(xv.y)}, z4[4] = {bflo(zv.x), bfhi(zv.x), bflo(zv.y), bfhi(zv.y)};
      f32x4 y;
#pragma unroll
      for (int j = 0; j < 4; ++j) y[j] = (y1[j] + elc * y2[u][j] + Dh * xs4[j]) * siluf(z4[j]);
      if (t < ntok) *(u32x2*)(oraw + (size_t)(rowbase + c * 64 + t) * D + 512 + h * 64 + p0) = pk4(y); }
    const float ell = __expf(ll);
    bf16x8 bf_[2];
#pragma unroll
    for (int ks = 0; ks < 2; ++ks) bf_[ks] = ldfrag_tr(BMI, 272, ks * 32, wid * 16, lane);
#pragma unroll
    for (int pt = 0; pt < 4; ++pt) { Sacc[pt] *= ell;
#pragma unroll
      for (int ks = 0; ks < 2; ++ks) Sacc[pt] = mma16(bf_[ks], ldfrag_tr(XW, 144, ks * 32, pt * 16, lane), Sacc[pt]);
      u32x2 w; w.x = pk2(Sacc[pt][0], Sacc[pt][1]); w.y = pk2(Sacc[pt][2], Sacc[pt][3]);
      *(LAS u32x2*)(SB + (pt * 16 + fr) * 272 + (wid * 16 + 4 * fq) * 2) = w; } }
}

DI void ssd_chain(const Params& p, int b, int h, bool sample, ldsp lds, int tid_) {
  int tid = tid_; asm volatile("" : "+v"(tid));
  const int wid = __builtin_amdgcn_readfirstlane(tid >> 6), lane = tid & 63, fr = lane & 15, fq = lane >> 4;
  const bf16_t* proj = (const bf16_t*)(p.ws + B_PROJ);
  const bf16_t* xact = (const bf16_t*)(p.ws + B_XACT);
  const float* dtg = (const float*)(p.ws + B_DT); const float* lcg = (const float*)(p.ws + B_LC);
  bf16_t* oraw = (bf16_t*)(p.ws + B_GOUT);
  const int nchunks = sample ? 1 : 32, ntok = sample ? 4 : 64, rowbase = sample ? TP + b * 4 : b * 2048, g = h >> 2;
  ldsp MM = lds, XW = lds + 9216, SB = lds + 18432;
  const float Dh = p.in[18][h];
  f32x4 Sacc[4];
  float* sout = p.out + (sample ? O_SSMS : O_SSMP) + (size_t)(b * 8 + h) * 8192;
#pragma unroll
  for (int pt = 0; pt < 4; ++pt) {
    if (sample) Sacc[pt] = *(const f32x4*)(p.in[4] + (size_t)(b * 8 + h) * 8192 + (pt * 16 + fr) * 128 + wid * 16 + 4 * fq);
    else Sacc[pt] = (f32x4){0.f, 0.f, 0.f, 0.f};
    u32x2 w; w.x = pk2(Sacc[pt][0], Sacc[pt][1]); w.y = pk2(Sacc[pt][2], Sacc[pt][3]);
    *(LAS u32x2*)(SB + (pt * 16 + fr) * 272 + (wid * 16 + 4 * fq) * 2) = w;
  }
  u32x4 rxA = Z4, rzA = Z4, rb0A = Z4, rb1A = Z4, rc0A = Z4, rc1A = Z4; float rdtA = 0.f, rlcA = 0.f;
  u32x4 rxB = Z4, rzB = Z4, rb0B = Z4, rb1B = Z4, rc0B = Z4, rc1B = Z4; float rdtB = 0.f, rlcB = 0.f;
  const int tq_ = tid >> 3, pq_ = tid & 7;
#define SSD_LOAD(c, S) do { const int r0 = rowbase + (c) * 64; \
    { const bool ok = tq_ < ntok; rx##S = ok ? ld16(xact + (size_t)(r0 + tq_) * D + h * 64 + pq_ * 8) : Z4; rz##S = ok ? ld16(proj + (size_t)(r0 + tq_) * NINP + C_Z + h * 64 + pq_ * 8) : Z4; } \
    { const int t0 = tid >> 4, p0 = tid & 15, t1 = (tid + 512) >> 4; const bf16_t* s0 = xact + (size_t)(r0 + t0) * D + 512 + g * 128 + p0 * 8; const bf16_t* s1 = xact + (size_t)(r0 + t1) * D + 512 + g * 128 + p0 * 8; \
      rb0##S = (t0 < ntok) ? ld16(s0) : Z4; rc0##S = (t0 < ntok) ? ld16(s0 + 256) : Z4; rb1##S = (t1 < ntok) ? ld16(s1) : Z4; rc1##S = (t1 < ntok) ? ld16(s1 + 256) : Z4; } \
    if (tid < 64) { const int tc = tid < ntok ? tid : ntok - 1; rdt##S = (tid < ntok) ? dtg[(size_t)(r0 + tid) * 8 + h] : 0.f; rlc##S = lcg[(size_t)(r0 + tc) * 8 + h]; } } while (0)
#define SSD_WRITE(bufi, S) do { ldsp NB_ = lds + 35840 + (bufi) * 53248; \
    *(LAS u32x4*)(NB_ + tq_ * 144 + pq_ * 16) = rx##S; *(LAS u32x4*)(NB_ + 9216 + tq_ * 128 + pq_ * 16) = rz##S; \
    *(LAS u32x4*)(NB_ + 17408 + (tid >> 4) * 272 + (tid & 15) * 16) = rb0##S; *(LAS u32x4*)(NB_ + 17408 + ((tid + 512) >> 4) * 272 + (tid & 15) * 16) = rb1##S; \
    *(LAS u32x4*)(NB_ + 34816 + (tid >> 4) * 272 + (tid & 15) * 16) = rc0##S; *(LAS u32x4*)(NB_ + 34816 + ((tid + 512) >> 4) * 272 + (tid & 15) * 16) = rc1##S; \
    if (tid < 64) { *(LAS float*)(NB_ + 52224 + tid * 4) = rdt##S; *(LAS float*)(NB_ + 52480 + tid * 4) = rlc##S; } } while (0)
  SSD_LOAD(0, B);
  SSD_WRITE(0, B);
  if (nchunks > 1) SSD_LOAD(1, A);
  if (nchunks > 2) SSD_LOAD(2, B);
  lbar();
  for (int c = 0; c < nchunks; c += 2) {
    ssd_step(lds, c, wid, lane, tid, ntok, rowbase, h, Dh, oraw, Sacc);
    if (c + 1 < nchunks) { SSD_WRITE(1, A); if (c + 3 < nchunks) SSD_LOAD(c + 3, A); }
    lbar();
    if (c + 1 < nchunks) {
      ssd_step(lds, c + 1, wid, lane, tid, ntok, rowbase, h, Dh, oraw, Sacc);
      if (c + 2 < nchunks) { SSD_WRITE(0, B); if (c + 4 < nchunks) SSD_LOAD(c + 4, B); }
      lbar();
    }
  }
#undef SSD_WRITE
#undef SSD_LOAD
#pragma unroll
  for (int pt = 0; pt < 4; ++pt) *(f32x4*)(sout + (pt * 16 + fr) * 128 + wid * 16 + 4 * fq) = Sacc[pt];
}

#ifndef REP_CH
#define REP_CH 1
#endif
#ifndef REP_SM
#define REP_SM 1
#endif
DI void phase_mixer(const Params& p, ldsp lds, int tid) {
  const int G = gridDim.x, bid = blockIdx.x;
  for (int rc_ = 0; rc_ < REP_CH; ++rc_)
  for (int i = bid; i < 96; i += G) {
    if (i < 32) gla_chain(p, i >> 2, i & 3, false, lds, tid);
    else ssd_chain(p, (i - 32) >> 3, (i - 32) & 7, false, lds, tid);
    __syncthreads();
  }
  const int sw0 = G > 96 ? 96 : 0, nsw = G - sw0;
  if (bid >= sw0)
    for (int rs_ = 0; rs_ < REP_SM; ++rs_)
    for (int j = bid - sw0; j < 1536; j += nsw) {
      if (j < 512) gla_chain(p, j >> 2, j & 3, true, lds, tid);
      else ssd_chain(p, (j - 512) >> 3, (j - 512) & 7, true, lds, tid);
      __syncthreads();
    }
  if (bid >= sw0) {
    unsigned char* ws = p.ws; const int lb = bid - sw0;
    tr_weight(p.in[20], (bf16_t*)(ws + W_OUT), 1024, 1024, 16, 0, 0, 0, lds, tid, nsw, lb);
    tr_weight(p.in[24], (bf16_t*)(ws + W_XQ), 1024, 1024, 16, 0, 0, 256, lds, tid, nsw, lb);
    tr_weight(p.in[27], (bf16_t*)(ws + W_XO), 1024, 1024, 16, 0, 0, 512, lds, tid, nsw, lb);
    tr_weight(p.in[30], (bf16_t*)(ws + W_GU), 1024, DFF, 44, 0, 1, 768, lds, tid, nsw, lb);
    tr_weight(p.in[31], (bf16_t*)(ws + W_GU), 1024, DFF, 44, 0, 2, 1472, lds, tid, nsw, lb);
    tr_weight(p.in[32], (bf16_t*)(ws + W_DN), DFF, 1024, 16, 0, 0, 2176, lds, tid, nsw, lb);
  }
}

DI void mixnorm_row(const Params& p, int r, const f32x4 (&v)[4], const u32x4 gv, int lane) {
  bf16_t* xa = (bf16_t*)(p.ws + B_XA);
  { float ss = v[0][0] * v[0][0] + v[0][1] * v[0][1] + v[0][2] * v[0][2] + v[0][3] * v[0][3] + v[1][0] * v[1][0] + v[1][1] * v[1][1] + v[1][2] * v[1][2] + v[1][3] * v[1][3];
#pragma unroll
    for (int s = 8; s >= 1; s >>= 1) ss += __shfl_xor(ss, s);
    const float rstd = rsqrtf(ss * (1.f / 128.f) + EPS);
    const f32x4 w0 = *(const f32x4*)(p.in[13] + ((lane * 8) & 127)), w1 = *(const f32x4*)(p.in[13] + ((lane * 8) & 127) + 4);
    f32x4 o0, o1;
    o0[0] = v[0][0] * rstd * w0[0] * siluf(bflo(gv.x)); o0[1] = v[0][1] * rstd * w0[1] * siluf(bfhi(gv.x)); o0[2] = v[0][2] * rstd * w0[2] * siluf(bflo(gv.y)); o0[3] = v[0][3] * rstd * w0[3] * siluf(bfhi(gv.y));
    o1[0] = v[1][0] * rstd * w1[0] * siluf(bflo(gv.z)); o1[1] = v[1][1] * rstd * w1[1] * siluf(bfhi(gv.z)); o1[2] = v[1][2] * rstd * w1[2] * siluf(bflo(gv.w)); o1[3] = v[1][3] * rstd * w1[3] * siluf(bfhi(gv.w));
    *(u32x4*)(xa + (size_t)r * D + lane * 8) = pk8(o0, o1); }
  { float ss = v[2][0] * v[2][0] + v[2][1] * v[2][1] + v[2][2] * v[2][2] + v[2][3] * v[2][3] + v[3][0] * v[3][0] + v[3][1] * v[3][1] + v[3][2] * v[3][2] + v[3][3] * v[3][3];
#pragma unroll
    for (int s = 16; s >= 1; s >>= 1) ss += __shfl_xor(ss, s);
    const float rstd = rsqrtf(ss * (1.f / 256.f) + EPS);
    const f32x4 w0 = *(const f32x4*)(p.in[19] + lane * 8), w1 = *(const f32x4*)(p.in[19] + lane * 8 + 4);
    *(u32x4*)(xa + (size_t)r * D + 512 + lane * 8) = pk8(v[2] * rstd * w0, v[3] * rstd * w1); }
}
DI void phase_mixnorm(const Params& p, int tid_) {
  int tid = tid_; asm volatile("" : "+v"(tid));
  const int G = gridDim.x, wid = tid >> 6, lane = tid & 63;
  const bf16_t* proj = (const bf16_t*)(p.ws + B_PROJ);
  const bf16_t* oraw = (const bf16_t*)(p.ws + B_GOUT);
  const int wv = blockIdx.x * 8 + wid, nwv = G * 8;
  if (wv < T) {
    f32x4 v[4]; u32x4 gv;
    ld_row_bf16(oraw + (size_t)wv * D, v, lane);
    gv = *(const u32x4*)(proj + (size_t)wv * NINP + C_G + lane * 8);
    for (int r = wv; r < T; r += nwv) {
      const int rn = (r + nwv < T) ? r + nwv : r;
      f32x4 vn[4]; u32x4 gn;
      ld_row_bf16(oraw + (size_t)rn * D, vn, lane);
      gn = *(const u32x4*)(proj + (size_t)rn * NINP + C_G + lane * 8);
      mixnorm_row(p, r, v, gv, lane);
#pragma unroll
      for (int e = 0; e < 4; ++e) v[e] = vn[e];
      gv = gn;
    }
  }
  for (int q = wv; q < 408; q += nwv) {
    int srow; float* dst;
    if (q < 24) { const int b = q / 3, j = q % 3; srow = b * 2048 + 2045 + j; dst = p.out + O_CONVP + (size_t)q * 1024; }
    else { const int q2 = q - 24, b = q2 / 3, j = q2 % 3; srow = TP + b * 4 + 1 + j; dst = p.out + O_CONVS + (size_t)q2 * 1024; }
#pragma unroll
    for (int i = 0; i < 2; ++i) { const u32x4 xv = ld16(proj + (size_t)srow * NINP + C_XBC + i * 512 + lane * 8);
      *(f32x4*)(dst + i * 512 + lane * 8) = (f32x4){bflo(xv.x), bfhi(xv.x), bflo(xv.y), bfhi(xv.y)};
      *(f32x4*)(dst + i * 512 + lane * 8 + 4) = (f32x4){bflo(xv.z), bfhi(xv.z), bflo(xv.w), bfhi(xv.w)}; }
  }
}

DI void resnorm_row(const Params& p, int which, int row, const f32x4 (&gv)[4], f32x4 (&hv)[4], int lane) {
  const float* wpost = which == 0 ? p.in[9] : (which == 1 ? p.in[22] : p.in[29]);
  const float* wpre = which == 0 ? p.in[21] : p.in[28];
  bf16_t* xa = (bf16_t*)(p.ws + B_XA);
  float ss = 0.f;
#pragma unroll
  for (int e = 0; e < 4; ++e) ss += gv[e][0] * gv[e][0] + gv[e][1] * gv[e][1] + gv[e][2] * gv[e][2] + gv[e][3] * gv[e][3];
  ss = wave_sum(ss); const float rstd = rsqrtf(ss * (1.f / 1024.f) + EPS);
  float s2 = 0.f;
#pragma unroll
  for (int e = 0; e < 4; ++e) { const f32x4 wv = *(const f32x4*)(wpost + RCOL(e));
#pragma unroll
    for (int j = 0; j < 4; ++j) { hv[e][j] += gv[e][j] * rstd * wv[j]; s2 += hv[e][j] * hv[e][j]; }
    if (which == 2) *(f32x4*)(p.out + (size_t)row * D + RCOL(e)) = hv[e]; }
  if (which < 2) {
#pragma unroll
    for (int i = 0; i < 2; ++i) *(u32x4*)((bf16_t*)(p.ws + B_H) + (size_t)row * D + i * 512 + lane * 8) = pk8(hv[2 * i], hv[2 * i + 1]);
    s2 = wave_sum(s2); const float r2 = rsqrtf(s2 * (1.f / 1024.f) + EPS);
#pragma unroll
    for (int i = 0; i < 2; ++i) { const f32x4 w0 = *(const f32x4*)(wpre + RCOL(2 * i)), w1 = *(const f32x4*)(wpre + RCOL(2 * i + 1));
      *(u32x4*)(xa + (size_t)row * D + i * 512 + lane * 8) = pk8(hv[2 * i] * r2 * w0, hv[2 * i + 1] * r2 * w1); }
  }
}
DI void phase_resnorm(const Params& p, int which, int tid_) {
  int tid = tid_; asm volatile("" : "+v"(tid));
  const int G = gridDim.x, wid = tid >> 6, lane = tid & 63;
  const bf16_t* gout = (const bf16_t*)(p.ws + B_GOUT);
  const float* bp = p.in[0]; const bf16_t* hb = (const bf16_t*)(p.ws + B_H);
  const int wv = blockIdx.x * 8 + wid, nwv = G * 8;
  if (wv < TP) {
    f32x4 gv[4], hv[4];
    ld_row_bf16(gout + (size_t)wv * D, gv, lane);
    if (which == 0) ld_row_f32(bp + (size_t)wv * D, hv, lane); else ld_row_bf16(hb + (size_t)wv * D, hv, lane);
    for (int r = wv; r < TP; r += nwv) {
      const int rn = (r + nwv < TP) ? r + nwv : r;
      f32x4 gn[4], hn[4];
      ld_row_bf16(gout + (size_t)rn * D, gn, lane);
      if (which == 0) ld_row_f32(bp + (size_t)rn * D, hn, lane); else ld_row_bf16(hb + (size_t)rn * D, hn, lane);
      resnorm_row(p, which, r, gv, hv, lane);
#pragma unroll
      for (int e = 0; e < 4; ++e) { gv[e] = gn[e]; hv[e] = hn[e]; }
    }
  }
  if ((wv & 3) == 0 && (wv >> 2) < TS) {
    const int rs = wv >> 2, KP = which == 2 ? 11 : 4;
    f32x4 gv[4], hv[4];
#pragma unroll
    for (int e = 0; e < 4; ++e) { gv[e] = (f32x4){0.f, 0.f, 0.f, 0.f}; const float* pp = (const float*)(p.ws + B_PART) + (size_t)rs * 1024 + RCOL(e);
      for (int kp = 0; kp < KP; ++kp) gv[e] += *(const f32x4*)(pp + (size_t)kp * 512 * 1024); }
    if (which == 0) ld_row_f32(p.in[1] + (size_t)rs * D, hv, lane); else ld_row_bf16(hb + (size_t)(TP + rs) * D, hv, lane);
    resnorm_row(p, which, TP + rs, gv, hv, lane);
  }
}

DI void attn_prompt_item(const Params& p, int item, ldsp lds, int tid_) {
  int tid = tid_; asm volatile("" : "+v"(tid));
  const int wid = __builtin_amdgcn_readfirstlane(tid >> 6), lane = tid & 63, l31 = lane & 31, h2 = lane >> 5;
  const int b = item >> 5, h = (item >> 3) & 3, qt = item & 7;
  bf16_t* qx = (bf16_t*)(p.ws + B_QX);
  const bf16_t* mkb = (const bf16_t*)(p.ws + B_MKB);
  const bf16_t* mvt = (const bf16_t*)(p.ws + B_MVT);
  const size_t qrow = (size_t)b * 2048 + qt * 256 + wid * 32 + l31;
  bf16x8 qreg[8];
#pragma unroll
  for (int s = 0; s < 8; ++s) qreg[s] = *(const bf16x8*)(qx + qrow * D + h * 256 + 16 * s + 8 * h2);
#pragma unroll
  for (int hb = 0; hb < 2; ++hb) {
    u32x4 kp[8];
#pragma unroll
    for (int i = 0; i < 8; ++i) { const int idx = tid + 512 * (hb * 8 + i), key = idx >> 5, c = idx & 31; kp[i] = ld16(mkb + (size_t)(b * 256 + key) * D + h * 256 + c * 8); }
#pragma unroll
    for (int i = 0; i < 8; ++i) { const int idx = tid + 512 * (hb * 8 + i), key = idx >> 5, c = idx & 31; *(LAS u32x4*)(lds + key * 512 + ((c ^ (key & 15)) * 16)) = kp[i]; }
  }
  __syncthreads();
  f32x16 S[8];
#pragma unroll
  for (int kt = 0; kt < 8; ++kt)
#pragma unroll
    for (int i = 0; i < 16; ++i) S[kt][i] = 0.f;
#pragma unroll
  for (int sh = 0; sh < 2; ++sh) {
    if (sh == 1) {
      __builtin_amdgcn_sched_barrier(0);
#pragma unroll
      for (int s = 0; s < 8; ++s) qreg[s] = *(const bf16x8*)(qx + qrow * D + h * 256 + 16 * (8 + s) + 8 * h2);
    }
    {
      bf16x8 kfa[4], kfb[4];
#define KF_ADDR(gi, j) (lds + (((gi) >> 1) * 32 + l31) * 512 + (((2 * (sh * 8 + ((gi) & 1) * 4 + (j)) + h2) ^ (l31 & 15)) * 16))
#pragma unroll
      for (int j = 0; j < 4; ++j) kfa[j] = *(const LAS bf16x8*)KF_ADDR(0, j);
#pragma unroll
      for (int gi = 0; gi < 16; ++gi) {
        if (gi + 1 < 16) {
#pragma unroll
          for (int j = 0; j < 4; ++j) { if (gi & 1) kfa[j] = *(const LAS bf16x8*)KF_ADDR(gi + 1, j); else kfb[j] = *(const LAS bf16x8*)KF_ADDR(gi + 1, j); } }
#pragma unroll
        for (int j = 0; j < 4; ++j) S[gi >> 1] = __builtin_amdgcn_mfma_f32_32x32x16_bf16((gi & 1) ? kfb[j] : kfa[j], qreg[(gi & 1) * 4 + j], S[gi >> 1], 0, 0, 0);
        __builtin_amdgcn_sched_barrier(0);
      }
#undef KF_ADDR
    }
  }
  float mx = -1e30f;
#pragma unroll
  for (int kt = 0; kt < 8; ++kt)
#pragma unroll
    for (int i = 0; i < 16; ++i) mx = fmaxf(mx, S[kt][i]);
  mx = fmaxf(mx, __shfl_xor(mx, 32));
  float sum = 0.f;
#pragma unroll
  for (int kt = 0; kt < 8; ++kt)
#pragma unroll
    for (int i = 0; i < 16; ++i) { const float e = __expf(S[kt][i] - mx); S[kt][i] = e; sum += e; }
  sum += __shfl_xor(sum, 32);
  const float inv = 1.f / sum;
  bf16x8 pb[8][2];
#pragma unroll
  for (int kt = 0; kt < 8; ++kt)
#pragma unroll
    for (int s = 0; s < 2; ++s) {
      u32x4 pw; pw.x = pk2(S[kt][8 * s], S[kt][8 * s + 1]); pw.y = pk2(S[kt][8 * s + 2], S[kt][8 * s + 3]); pw.z = pk2(S[kt][8 * s + 4], S[kt][8 * s + 5]); pw.w = pk2(S[kt][8 * s + 6], S[kt][8 * s + 7]);
      pb[kt][s] = __builtin_bit_cast(bf16x8, pw);
    }
  __syncthreads();
#pragma unroll
  for (int hb = 0; hb < 2; ++hb) {
    u32x4 vp[8];
#pragma unroll
    for (int i = 0; i < 8; ++i) { const int idx = tid + 512 * (hb * 8 + i), d = idx >> 5, c = idx & 31; vp[i] = ld16(mvt + ((size_t)((b * 4 + h) * 256 + d)) * 256 + c * 8); }
#pragma unroll
    for (int i = 0; i < 8; ++i) { const int idx = tid + 512 * (hb * 8 + i), d = idx >> 5, c = idx & 31; *(LAS u32x4*)(lds + d * 512 + ((c ^ (d & 15)) * 16)) = vp[i]; }
  }
  __syncthreads();
#pragma unroll
  for (int dh = 0; dh < 2; ++dh) {
    f32x16 O[4];
#pragma unroll
    for (int dt = 0; dt < 4; ++dt)
#pragma unroll
      for (int i = 0; i < 16; ++i) O[dt][i] = 0.f;
    {
      u32x2 va[4][2], vb[4][2];
#define VF_ADDR(gi, dt, hl) (lds + ((dh * 4 + (dt)) * 32 + l31) * 512 + ((((2 * (gi)) + (hl)) ^ (l31 & 15)) * 16) + 8 * h2)
#pragma unroll
      for (int dt = 0; dt < 4; ++dt) { va[dt][0] = *(const LAS u32x2*)VF_ADDR(0, dt, 0); va[dt][1] = *(const LAS u32x2*)VF_ADDR(0, dt, 1); }
#pragma unroll
      for (int gi = 0; gi < 16; ++gi) {
        if (gi + 1 < 16) {
#pragma unroll
          for (int dt = 0; dt < 4; ++dt) {
            if (gi & 1) { va[dt][0] = *(const LAS u32x2*)VF_ADDR(gi + 1, dt, 0); va[dt][1] = *(const LAS u32x2*)VF_ADDR(gi + 1, dt, 1); }
            else { vb[dt][0] = *(const LAS u32x2*)VF_ADDR(gi + 1, dt, 0); vb[dt][1] = *(const LAS u32x2*)VF_ADDR(gi + 1, dt, 1); } } }
#pragma unroll
        for (int dt = 0; dt < 4; ++dt) { const u32x2 lo = (gi & 1) ? vb[dt][0] : va[dt][0], hi = (gi & 1) ? vb[dt][1] : va[dt][1];
          u32x4 vw; vw.x = lo.x; vw.y = lo.y; vw.z = hi.x; vw.w = hi.y;
          O[dt] = __builtin_amdgcn_mfma_f32_32x32x16_bf16(__builtin_bit_cast(bf16x8, vw), pb[gi >> 1][gi & 1], O[dt], 0, 0, 0); }
        __builtin_amdgcn_sched_barrier(0);
      }
#undef VF_ADDR
    }
#pragma unroll
    for (int dt = 0; dt < 4; ++dt)
#pragma unroll
      for (int g4 = 0; g4 < 4; ++g4) { u32x2 w; w.x = pk2(O[dt][4 * g4] * inv, O[dt][4 * g4 + 1] * inv); w.y = pk2(O[dt][4 * g4 + 2] * inv, O[dt][4 * g4 + 3] * inv);
        *(u32x2*)((bf16_t*)(p.ws + B_XA) + qrow * D + h * 256 + (dh * 4 + dt) * 32 + 8 * g4 + 4 * h2) = w; }
  }
  __syncthreads();
}

DI void attn_sample_item(const Params& p, int item, ldsp lds, int tid_) {
  int tid = tid_; asm volatile("" : "+v"(tid));
  const int wid = tid >> 6, lane = tid & 63;
  const int b = item >> 2, h = item & 3;
  bf16_t* qx = (bf16_t*)(p.ws + B_QX);
  const float* ck = p.in[6] + ((size_t)b * 256 * 4 + h) * 256;
  const float* cv = p.in[7] + ((size_t)b * 256 * 4 + h) * 256;
  LAS float* SC = (LAS float*)lds;
  LAS float* PART = (LAS float*)(lds + 4096);
  float q[4][4];
#pragma unroll
  for (int t = 0; t < 4; ++t) { f32x4 a = {0.f, 0.f, 0.f, 0.f}; const float* pp = (const float*)(p.ws + B_PART) + (size_t)(b * 4 + t) * 1024 + h * 256 + lane * 4;
#pragma unroll
    for (int kp = 0; kp < 4; ++kp) a += *(const f32x4*)(pp + (size_t)kp * 512 * 1024);
    q[t][0] = a[0] * 0.0625f; q[t][1] = a[1] * 0.0625f; q[t][2] = a[2] * 0.0625f; q[t][3] = a[3] * 0.0625f; }
  const bool b0 = lane & 1, b1 = lane & 2;
  f32x4 kvA[16], kvB[16];
#pragma unroll
  for (int j = 0; j < 16; ++j) kvA[j] = __builtin_nontemporal_load((const f32x4*)(ck + (size_t)(wid * 32 + j) * 1024 + lane * 4));
#pragma unroll
  for (int j = 0; j < 16; ++j) kvB[j] = __builtin_nontemporal_load((const f32x4*)(ck + (size_t)(wid * 32 + 16 + j) * 1024 + lane * 4));
#define SC_SCORE(KV, KB) _Pragma("unroll") for (int j = 0; j < 16; ++j) { float a[4]; \
      _Pragma("unroll") for (int t = 0; t < 4; ++t) a[t] = KV[j][0] * q[t][0] + KV[j][1] * q[t][1] + KV[j][2] * q[t][2] + KV[j][3] * q[t][3]; \
      float x0 = b0 ? a[2] : a[0], x1 = b0 ? a[3] : a[1]; const float y0 = b0 ? a[0] : a[2], y1 = b0 ? a[1] : a[3]; \
      x0 += __shfl_xor(y0, 1); x1 += __shfl_xor(y1, 1); \
      float z = b1 ? x1 : x0; const float w = b1 ? x0 : x1; \
      z += __shfl_xor(w, 2); z += __shfl_xor(z, 4); z += __shfl_xor(z, 8); z += __shfl_xor(z, 16); z += __shfl_xor(z, 32); \
      if (lane < 4) SC[((lane & 1) * 2 + (lane >> 1)) * 256 + wid * 32 + (KB) * 16 + j] = z; }
  SC_SCORE(kvA, 0)
  SC_SCORE(kvB, 1)
#undef SC_SCORE
  f32x4 vvA[16], vvB[16];
#pragma unroll
  for (int j = 0; j < 16; ++j) vvA[j] = __builtin_nontemporal_load((const f32x4*)(cv + (size_t)(wid * 32 + j) * 1024 + lane * 4));
  lbar();
  if (wid < 4) {
    float v[4]; float mx = -1e30f;
#pragma unroll
    for (int j = 0; j < 4; ++j) { v[j] = SC[wid * 256 + j * 64 + lane]; mx = fmaxf(mx, v[j]); }
    for (int o = 32; o >= 1; o >>= 1) mx = fmaxf(mx, __shfl_xor(mx, o));
    float s = 0.f;
#pragma unroll
    for (int j = 0; j < 4; ++j) { v[j] = __expf(v[j] - mx); s += v[j]; }
    s = wave_sum(s); const float inv = 1.f / s;
#pragma unroll
    for (int j = 0; j < 4; ++j) SC[wid * 256 + j * 64 + lane] = v[j] * inv;
  }
#pragma unroll
  for (int j = 0; j < 16; ++j) vvB[j] = __builtin_nontemporal_load((const f32x4*)(cv + (size_t)(wid * 32 + 16 + j) * 1024 + lane * 4));
  lbar();
  {
    f32x4 acc[4];
#pragma unroll
    for (int t = 0; t < 4; ++t) acc[t] = (f32x4){0.f, 0.f, 0.f, 0.f};
#pragma unroll
    for (int t = 0; t < 4; ++t)
#pragma unroll
      for (int j4 = 0; j4 < 4; ++j4) { const f32x4 pp = *(const LAS f32x4*)(SC + t * 256 + wid * 32 + j4 * 4);
#pragma unroll
        for (int e = 0; e < 4; ++e) acc[t] += pp[e] * vvA[j4 * 4 + e]; }
#pragma unroll
    for (int t = 0; t < 4; ++t)
#pragma unroll
      for (int j4 = 0; j4 < 4; ++j4) { const f32x4 pp = *(const LAS f32x4*)(SC + t * 256 + wid * 32 + 16 + j4 * 4);
#pragma unroll
        for (int e = 0; e < 4; ++e) acc[t] += pp[e] * vvB[j4 * 4 + e]; }
#pragma unroll
    for (int t = 0; t < 4; ++t) *(LAS f32x4*)(PART + (wid * 4 + t) * 256 + lane * 4) = acc[t];
  }
  lbar();
  {
    const int e0 = tid * 2, t = e0 >> 8, d = e0 & 255;
    float s0 = 0.f, s1 = 0.f;
#pragma unroll
    for (int w = 0; w < 8; ++w) { const f32x2 v = *(const LAS f32x2*)(PART + (w * 4 + t) * 256 + d); s0 += v[0]; s1 += v[1]; }
    *(unsigned*)((bf16_t*)(p.ws + B_XA) + (size_t)(TP + b * 4 + t) * D + h * 256 + d) = pk2(s0, s1);
  }
  lbar();
}

DI void phase_attn(const Params& p, ldsp lds, int tid) {
  const int G = gridDim.x;
  if (blockIdx.x & 1) for (int j = blockIdx.x; j < 512; j += G) attn_sample_item(p, j, lds, tid);
  for (int i = blockIdx.x; i < 256; i += G) attn_prompt_item(p, i, lds, tid);
  if (!(blockIdx.x & 1)) for (int j = blockIdx.x; j < 512; j += G) attn_sample_item(p, j, lds, tid);
}


constexpr size_t WS_BAR = WS_END;
#define XB_TMO      128
#define XB_XCNT(j)  (256  + 64 * (j))
#define XB_XSUB(j)  (1280 + 64 * (j))
#define XB_XGEN(j)  (2304 + 64 * (j))
#define XB_TOP      3328
#define XB_TOPGEN   3392
#define XCD_BAR_WORDS 3456
#define XB_SPIN_CAP (1u << 20)
DI unsigned xb_ld(unsigned* p)              { return __hip_atomic_load(p, __ATOMIC_RELAXED, __HIP_MEMORY_SCOPE_AGENT); }
DI unsigned xb_add(unsigned* p, unsigned v) { return __hip_atomic_fetch_add(p, v, __ATOMIC_RELAXED, __HIP_MEMORY_SCOPE_AGENT); }
DI unsigned xb_xcc_id() { return (unsigned)__builtin_amdgcn_s_getreg((3 << 11) | 20) & 0xFu; }
#define XB_SPIN(cond, bar) do { unsigned _sp = 0; while (cond) { __builtin_amdgcn_s_sleep(1); \
    if ((++_sp & 255u) == 0u) { if (xb_ld(&(bar)[XB_TMO])) break; if (_sp > XB_SPIN_CAP) { atomicAdd(&(bar)[XB_TMO], 1u); break; } } } } while (0)
struct XcdBarrier { unsigned* bar; unsigned x; volatile LAS unsigned* st; };
DI void xcd_barrier_complete(unsigned* bar, unsigned x, unsigned& nloc, unsigned& nx) {
  const unsigned G = gridDim.x;
  unsigned sum, cnt, mine, sp = 0u;
  for (;;) {
    sum = 0u; cnt = 0u; mine = 0u;
#pragma unroll
    for (unsigned j = 0; j < 16; ++j) { const unsigned c = xb_ld(&bar[XB_XCNT(j)]); sum += c; cnt += (c > 0u) ? 1u : 0u; mine = (j == x) ? c : mine; }
    if (sum == G) break;
    __builtin_amdgcn_s_sleep(1);
    if ((++sp & 255u) == 0u) { if (xb_ld(&bar[XB_TMO])) break; if (sp > XB_SPIN_CAP) { atomicAdd(&bar[XB_TMO], 1u); break; } }
  }
  nloc = mine > 0u ? mine : 1u; nx = cnt > 0u ? cnt : 1u;
}
DI void xcd_barrier(const XcdBarrier& b) {
  asm volatile("s_waitcnt vmcnt(0)" ::: "memory");
  __syncthreads();
  if (threadIdx.x == 0) {
    unsigned* bar = b.bar;
    __builtin_amdgcn_s_waitcnt(0);
    unsigned nloc = b.st[0], nx = b.st[1];
    if (nloc == 0u) { xcd_barrier_complete(bar, b.x, nloc, nx); b.st[0] = nloc; b.st[1] = nx; }
    const unsigned old = xb_add(&bar[XB_XSUB(b.x)], 1u);
    const unsigned gen = old / nloc;
    if (old + 1u == (gen + 1u) * nloc) {
      __builtin_amdgcn_fence(__ATOMIC_RELEASE, "agent");
      asm volatile("s_waitcnt vmcnt(0)" ::: "memory");
      const unsigned og = xb_add(&bar[XB_TOP], 1u);
      const unsigned tg = og / nx;
      if (og + 1u == (tg + 1u) * nx) {
#pragma unroll
        for (unsigned j = 0; j < 16; ++j) (void)xb_add(&bar[XB_XGEN(j)], 1u);
      } else XB_SPIN(xb_ld(&bar[XB_XGEN(b.x)]) == gen, bar);
      __builtin_amdgcn_fence(__ATOMIC_ACQUIRE, "agent");
      asm volatile("s_waitcnt vmcnt(0)" ::: "memory");
    } else {
      XB_SPIN(xb_ld(&bar[XB_XGEN(b.x)]) == gen, bar);
      __builtin_amdgcn_fence(__ATOMIC_ACQUIRE, "agent");
      asm volatile("s_waitcnt vmcnt(0)" ::: "memory");
    }
  }
  __syncthreads();
}

__global__ void __launch_bounds__(512, 2) fwd_mega(Params p) {
  extern __shared__ __attribute__((aligned(16))) unsigned char lds_raw[];
  ldsp lds = (ldsp)lds_raw;
  cg::grid_group grid = cg::this_grid();
  const int tid = threadIdx.x, G = gridDim.x, bid = blockIdx.x;
  unsigned char* ws = p.ws;
  bf16_t* xa = (bf16_t*)(ws + B_XA);
  bf16_t* gout = (bf16_t*)(ws + B_GOUT);
  float* part = (float*)(ws + B_PART);
  unsigned* barw = (unsigned*)(ws + WS_BAR);
  __shared__ uint4 xb_words;
  if (tid == 0) xb_words = make_uint4(0u, 0u, 0u, 0u);
  XcdBarrier xbar; xbar.bar = barw; xbar.x = xb_xcc_id(); xbar.st = (volatile LAS unsigned*)&xb_words;
  if (p.ws == nullptr) grid.sync();
  if (tid == 0) (void)xb_add(&barw[XB_XCNT(xbar.x)], 1u);
  __syncthreads();

#ifndef PHMASK
#define PHMASK 0xffff
#endif
#ifndef REPMASK
#define REPMASK 0
#endif
#ifndef XSYNC
#define XSYNC 0
#endif
#define PH(n) for (int rep_ = 0; rep_ < (((PHMASK >> (n)) & 1) + ((REPMASK >> (n)) & 1)); ++rep_)
  PH(0) phase_prep(p, lds, tid);
  xcd_barrier(xbar);
  PH(1) {
    pg8::Sched S{xa, (const bf16_t*)(ws + W_IN), T / 256, NINP / 256, (const bf16_t*)(ws + B_MN), (const bf16_t*)(ws + W_KV), 8, 8, G, bid, 1024, 0, 1};
    pg8::EpiP1 E{(bf16_t*)(ws + B_PROJ), p.out + O_MK, p.out + O_MV, (bf16_t*)(ws + B_MKB), (bf16_t*)(ws + B_MVT)};
    pg8::gemm_phase(lds, S, E);
  }
  xcd_barrier(xbar);
  PH(13) phase_precompute(p, lds, tid);
  xcd_barrier(xbar);
  PH(2) phase_mixer(p, lds, tid);
  xcd_barrier(xbar);
  PH(3) phase_mixnorm(p, tid);
  xcd_barrier(xbar);
  PH(4) {
    pg8::Sched S{xa, (const bf16_t*)(ws + W_OUT), TP / 256, 4, nullptr, nullptr, 0, 0, G, bid, 1024, 2, 4};
    pg8::EpiF32 E{gout, D, part};
    pg8::gemm_phase(lds, S, E);
  }
  xcd_barrier(xbar);
  PH(5) phase_resnorm(p, 0, tid);
  xcd_barrier(xbar);
  PH(6) {
    pg8::Sched S{xa, (const bf16_t*)(ws + W_XQ), TP / 256, 4, nullptr, nullptr, 0, 0, G, bid, 1024, 2, 4};
    pg8::EpiBf16 E{(bf16_t*)(ws + B_QX), D, 0.0625f, part};
    pg8::gemm_phase(lds, S, E);
  }
  xcd_barrier(xbar);
  PH(7) phase_attn(p, lds, tid);
  xcd_barrier(xbar);
  PH(8) {
    pg8::Sched S{xa, (const bf16_t*)(ws + W_XO), TP / 256, 4, nullptr, nullptr, 0, 0, G, bid, 1024, 2, 4};
    pg8::EpiF32 E{gout, D, part};
    pg8::gemm_phase(lds, S, E);
  }
  xcd_barrier(xbar);
  PH(9) phase_resnorm(p, 1, tid);
  xcd_barrier(xbar);
  PH(10) {
    pg8::Sched S{xa, (const bf16_t*)(ws + W_GU), T / 256, 22, nullptr, nullptr, 0, 0, G, bid, 1024, 0, 1};
    pg8::EpiGU E{(bf16_t*)(ws + B_PROJ)};
    pg8::gemm_phase(lds, S, E);
  }
  xcd_barrier(xbar);
  PH(11) {
    pg8::Sched S{(const bf16_t*)(ws + B_PROJ), (const bf16_t*)(ws + W_DN), TP / 256, 4, nullptr, nullptr, 0, 0, G, bid, DFF, 2, 11};
    pg8::EpiF32 E{gout, D, part};
    pg8::gemm_phase(lds, S, E);
  }
  xcd_barrier(xbar);
  for (int xs_ = 0; xs_ < XSYNC; ++xs_) xcd_barrier(xbar);
  PH(12) phase_resnorm(p, 2, tid);
}

extern "C" void kernel_launch(void* const* d_in, const int* in_sizes, int n_in, void* d_out, int out_size, void* d_ws, size_t ws_size, hipStream_t stream) {
  static int grid_blocks = 0;
  if (!grid_blocks) {
    int dev = 0, cus = 0, per_cu = 0;
    (void)hipGetDevice(&dev);
    (void)hipDeviceGetAttribute(&cus, hipDeviceAttributeMultiprocessorCount, dev);
    (void)hipFuncSetAttribute((const void*)fwd_mega, hipFuncAttributeMaxDynamicSharedMemorySize, LDS_BYTES);
    (void)hipOccupancyMaxActiveBlocksPerMultiprocessor(&per_cu, (const void*)fwd_mega, 512, LDS_BYTES);
    if (per_cu < 1) per_cu = 1;
    grid_blocks = cus * per_cu;
    if (ws_size < WS_END + XCD_BAR_WORDS * 4) fprintf(stderr, "workspace too small: %zu < %zu\n", ws_size, (size_t)WS_END);
  }
  Params p{};
  for (int i = 0; i < 33; ++i) p.in[i] = (const float*)d_in[i];
  p.out = (float*)d_out; p.ws = (unsigned char*)d_ws;
  (void)hipMemsetAsync((unsigned char*)d_ws + WS_BAR, 0, XCD_BAR_WORDS * 4, stream);
  void* args[] = {&p};
  hipError_t e = hipLaunchCooperativeKernel((const void*)fwd_mega, dim3(grid_blocks), dim3(512), args, LDS_BYTES, stream);
  if (e != hipSuccess) fprintf(stderr, "cooperative launch failed: %s (grid %d)\n", hipGetErrorString(e), grid_blocks);
}
```

```cpp
#include <hip/hip_runtime.h>
#include <hip/hip_cooperative_groups.h>
#include <cstdio>
namespace cg = cooperative_groups;

#define DI __device__ __forceinline__
#define LAS __attribute__((address_space(3)))
typedef unsigned short bf16_t;
typedef short bf16x8 __attribute__((ext_vector_type(8)));
typedef short s16x4 __attribute__((ext_vector_type(4)));
typedef float f32x2 __attribute__((ext_vector_type(2)));
typedef float f32x4 __attribute__((ext_vector_type(4)));
typedef float f32x16 __attribute__((ext_vector_type(16)));
typedef unsigned u32x2 __attribute__((ext_vector_type(2)));
typedef unsigned u32x4 __attribute__((ext_vector_type(4)));
typedef __bf16 bf16x2v __attribute__((ext_vector_type(2)));
typedef LAS unsigned char* ldsp;

DI unsigned pk2(float lo, float hi) { f32x2 v = {lo, hi}; return __builtin_bit_cast(unsigned, __builtin_convertvector(v, bf16x2v)); }
DI bf16_t f2bf(float x) { return (bf16_t)(pk2(x, 0.f) & 0xffffu); }
DI float bf2f(bf16_t b) { return __uint_as_float(((unsigned)b) << 16); }
DI float bflo(unsigned u) { return __uint_as_float(u << 16); }
DI float bfhi(unsigned u) { return __uint_as_float(u & 0xffff0000u); }
DI float siluf(float x) { return x * __builtin_amdgcn_rcpf(1.f + __expf(-x)); }
DI void lbar() { asm volatile("s_waitcnt lgkmcnt(0)" ::: "memory"); __builtin_amdgcn_s_barrier(); asm volatile("" ::: "memory"); }
DI float softplusf(float x) { return fmaxf(x, 0.f) + __logf(1.f + __expf(-fabsf(x))); }
DI f32x4 unpk4(u32x2 u) { return (f32x4){bflo(u.x), bfhi(u.x), bflo(u.y), bfhi(u.y)}; }
DI u32x2 pk4(f32x4 v) { u32x2 w; w.x = pk2(v[0], v[1]); w.y = pk2(v[2], v[3]); return w; }
#define RCOL(e) (((e) >> 1) * 512 + lane * 8 + ((e) & 1) * 4)
DI u32x4 pk8(f32x4 a, f32x4 b) { u32x4 w; w.x = pk2(a[0], a[1]); w.y = pk2(a[2], a[3]); w.z = pk2(b[0], b[1]); w.w = pk2(b[2], b[3]); return w; }
DI void ld_row_bf16(const bf16_t* rowp, f32x4 (&v)[4], int lane) {
#pragma unroll
  for (int i = 0; i < 2; ++i) { const u32x4 u = *(const u32x4*)(rowp + i * 512 + lane * 8);
    v[2 * i] = (f32x4){bflo(u.x), bfhi(u.x), bflo(u.y), bfhi(u.y)}; v[2 * i + 1] = (f32x4){bflo(u.z), bfhi(u.z), bflo(u.w), bfhi(u.w)}; }
}
DI void ld_row_f32(const float* rowp, f32x4 (&v)[4], int lane) {
#pragma unroll
  for (int e = 0; e < 4; ++e) v[e] = *(const f32x4*)(rowp + RCOL(e));
}
DI float wave_sum(float v) { for (int o = 32; o >= 1; o >>= 1) v += __shfl_xor(v, o); return v; }

constexpr int D = 1024, TP = 16384, TS = 512, T = TP + TS, NIN = 3096, NINP = 3328, DFF = 2816;
constexpr int C_Q = 0, C_K = 256, C_V = 512, C_G = 1024, C_GLR = 1536, C_Z = 1552, C_XBC = 2064, C_DT = 3088;
constexpr float EPS = 1e-6f;
constexpr size_t O_Y = 0, O_GLAP = 17301504, O_SSMP = 17563648, O_CONVP = 18087936, O_MK = 18112512, O_MV = 20209664,
                 O_GLAS = 22306816, O_SSMS = 26501120, O_CONVS = 34889728;
constexpr size_t W_IN = 0, W_KV = W_IN + (size_t)NINP * D * 2, W_OUT = W_KV + 2048ull * D * 2, W_XQ = W_OUT + (size_t)D * D * 2, W_XO = W_XQ + (size_t)D * D * 2,
                 W_GU = W_XO + (size_t)D * D * 2, W_DN = W_GU + 5632ull * D * 2, B_XA = W_DN + (size_t)D * DFF * 2, B_MN = B_XA + (size_t)T * D * 2,
                 B_PROJ = B_MN + 2048ull * D * 2, B_MKB = B_PROJ + (size_t)T * NINP * 2, B_MVT = B_MKB + 2048ull * D * 2, B_GOUT = B_MVT + 2048ull * D * 2,
                 B_QX = B_GOUT + (size_t)T * D * 4, B_QT = B_QX + (size_t)T * D * 2, B_KT = B_QT + (size_t)T * 256 * 2, B_KD = B_KT + (size_t)T * 256 * 2,
                 B_XACT = B_KD + (size_t)T * 256 * 2, B_EB = B_XACT + (size_t)T * D * 2, B_DT = B_EB + 384ull * 256 * 4, B_LC = B_DT + (size_t)T * 8 * 4, B_PART = B_LC + (size_t)T * 8 * 4, B_H = B_PART + 11ull * 512 * 1024 * 4, WS_END = B_H + (size_t)T * D * 2;

struct Params {
  const float* in[33];
  float* out;
  unsigned char* ws;
};

constexpr int LDS_BYTES = 147456;

DI bf16x8 ldfrag(ldsp base, int ld, int row0, int k0, int lane) {
  return *(const LAS bf16x8*)(base + (row0 + (lane & 15)) * ld + (k0 + 8 * (lane >> 4)) * 2);
}
DI bf16x8 ldfrag_tr(ldsp base, int ld, int k0, int n0, int lane) {
  const int g = lane >> 4, q = (lane & 15) >> 2, pp = lane & 3;
  ldsp a = base + (k0 + 8 * g + q) * ld + (n0 + 4 * pp) * 2;
  s16x4 lo = __builtin_amdgcn_ds_read_tr16_b64_v4i16((LAS s16x4*)a);
  s16x4 hi = __builtin_amdgcn_ds_read_tr16_b64_v4i16((LAS s16x4*)(a + 4 * ld));
  return __builtin_shufflevector(lo, hi, 0, 1, 2, 3, 4, 5, 6, 7);
}
DI f32x4 mma16(bf16x8 bfrag, bf16x8 afrag, f32x4 acc) { return __builtin_amdgcn_mfma_f32_16x16x32_bf16(bfrag, afrag, acc, 0, 0, 0); }

namespace pg8 {
constexpr int BM = 256, BK = 64, HALF = 128, HTB = HALF * BK * 2, STAGE_BYTES = 8 * HTB, NXCD = 8, WGM = 8;
DI int lds_byte(int r, int c) { const int st = (r >> 4) * 2 + (c >> 5), rr = r & 15, cc = c & 31, ob = rr * 64 + cc * 2; return st * 1024 + (ob ^ (((ob >> 9) & 1) << 5)); }
DI void stage_rc(int b, int& R, int& C) { const int st = b / 1024, sb = b % 1024, swz = sb ^ (((sb >> 9) & 1) << 5); R = (st >> 1) * 16 + swz / 64; C = (st & 1) * 32 + (swz % 64) / 2; }
struct Unit { int pm, pn, g, kp; };
DI void map_unit(int L, int nM, int nN, int& pm, int& pn) {
  const int nwg = nM * nN; int wgid = L;
  { const int q = nwg / NXCD, r = nwg % NXCD, xcd = wgid % NXCD, off = wgid / NXCD; wgid = (xcd < r ? xcd * (q + 1) : r * (q + 1) + (xcd - r) * q) + off; }
  const int nig = WGM * nN, gid = wgid / nig, fm = gid * WGM, gsz = (nM - fm) < WGM ? (nM - fm) : WGM;
  pm = fm + ((wgid % nig) % gsz); pn = (wgid % nig) / gsz;
}
struct Sched {
  const bf16_t* A0; const bf16_t* B0; int nM0, nN0; const bf16_t* A1; const bf16_t* B1; int nM1, nN1; int G, c, K; int tM, KP;
  DI bool next(int i, Unit& u) const {
    int L = i * G + c; const int n0 = nM0 * nN0, n1 = nM1 * nN1; u.kp = 0;
    const int p1 = (n1 > 0 && n1 <= G && n0 + n1 > G) ? G - n1 : n0;
    if (L >= p1 && L < p1 + n1) { u.g = 1; map_unit(L - p1, nM1, nN1, u.pm, u.pn); return true; }
    if (L >= p1 + n1) L -= n1;
    if (L < n0) { u.g = 0; map_unit(L, nM0, nN0, u.pm, u.pn); return true; }
    L -= n0; if (L < tM * nN0 * KP) { u.g = 2; u.kp = L % KP; const int tile = L / KP; u.pm = nM0 + tile / nN0; u.pn = tile % nN0; return true; }
    return false;
  }
  DI int nt(const Unit& u) const { return u.g == 2 ? K / KP / BK : K / BK; }
  DI const char* aptr(const Unit& u) const { return (const char*)(u.g == 1 ? A1 : A0) + (size_t)u.pm * 512 * K + (u.g == 2 ? (size_t)u.kp * (K / KP) * 2 : 0); }
  DI const char* bptr(const Unit& u) const { return (const char*)(u.g == 1 ? B1 : B0) + (size_t)u.pn * 512 * K + (u.g == 2 ? (size_t)u.kp * (K / KP) * 2 : 0); }
};

template <class Epi>
DI void gemm_phase(ldsp lds, const Sched& S, const Epi& E) {
  int tid = threadIdx.x; asm volatile("" : "+v"(tid));
  const int wid = __builtin_amdgcn_readfirstlane(tid >> 6), lane = tid & 63, wr = wid >> 2, wc = wid & 3, fr = lane & 15, fq = lane >> 4;
  const int K = S.K;
  unsigned voffA[2], voffB[2];
#pragma unroll
  for (int i = 0; i < 2; ++i) { int R, C; stage_rc(tid * 16 + i * 8192, R, C); voffA[i] = (unsigned)(R * K + C) * 2u;
    const int rho = R & 31, Rb = (R & ~31) + 8 * ((rho & 15) >> 2) + 4 * (rho >> 4) + (rho & 3); voffB[i] = (unsigned)(Rb * K + C) * 2u; }
  const size_t kstep = (size_t)(BK * 2);
  const size_t hstep = (size_t)HALF * K * 2;
  const unsigned ldsw = (unsigned)wid * 1024u;
  const int aoff = lds_byte(wr * 64 + fr, fq * 8), boff = lds_byte(wc * 32 + fr, fq * 8);
#define PG8_SA(b, h) (((b) * 2 + (h)) * HTB)
#define PG8_SB(b, h) ((4 + (b) * 2 + (h)) * HTB)
#define PG8_STAGE(bufoff, gbase, voff) do { _Pragma("unroll") for (int _i = 0; _i < 2; ++_i) \
        __builtin_amdgcn_global_load_lds((const unsigned*)((const char*)(gbase) + (voff)[_i]), (LAS unsigned*)(lds + (bufoff) + ldsw + _i * 8192), 16, 0, 0); } while (0)
#define PG8_LDA(dst, b, h) do { _Pragma("unroll") for (int m = 0; m < 4; ++m) _Pragma("unroll") for (int k = 0; k < 2; ++k) dst[m][k] = *(const LAS bf16x8*)(lds + PG8_SA(b, h) + aoff + m * 2048 + k * 1024); } while (0)
#define PG8_LDB(dst, b, h) do { _Pragma("unroll") for (int n = 0; n < 2; ++n) _Pragma("unroll") for (int k = 0; k < 2; ++k) dst[n][k] = *(const LAS bf16x8*)(lds + PG8_SB(b, h) + boff + n * 2048 + k * 1024); } while (0)
#define PG8_MMA(ai, bj, At, Bt) do { __builtin_amdgcn_s_setprio(1); _Pragma("unroll") for (int m = 0; m < 4; ++m) _Pragma("unroll") for (int n = 0; n < 2; ++n) _Pragma("unroll") for (int k = 0; k < 2; ++k) \
        acc[ai][bj][m][n] = __builtin_amdgcn_mfma_f32_16x16x32_bf16(Bt[n][k], At[m][k], acc[ai][bj][m][n], 0, 0, 0); __builtin_amdgcn_s_setprio(0); } while (0)
#define PG8_WAIT_V(n) asm volatile("s_waitcnt vmcnt(" #n ")" ::: "memory")
#define PG8_WAIT_L(n) asm volatile("s_waitcnt lgkmcnt(" #n ")" ::: "memory")
#define PG8_BAR __builtin_amdgcn_s_barrier()
#define PG8_SCHED __builtin_amdgcn_sched_barrier(0)
  Unit cur, nxt; int ui = 0;
  if (!S.next(0, cur)) return;
  f32x4 acc[2][2][4][2];
#pragma unroll
  for (int a = 0; a < 2; ++a)
#pragma unroll
    for (int b = 0; b < 2; ++b)
#pragma unroll
      for (int m = 0; m < 4; ++m)
#pragma unroll
        for (int n = 0; n < 2; ++n) acc[a][b][m][n] = (f32x4){0.f, 0.f, 0.f, 0.f};
  bf16x8 At[4][2], B0[2][2], B1[2][2];
  const char* cA = S.aptr(cur); const char* cB = S.bptr(cur);
  PG8_STAGE(PG8_SB(0, 0), cB, voffB); PG8_STAGE(PG8_SA(0, 0), cA, voffA); PG8_STAGE(PG8_SB(0, 1), cB + hstep, voffB); PG8_STAGE(PG8_SA(0, 1), cA + hstep, voffA);
  if (wr == 1) PG8_BAR;
  PG8_WAIT_V(4); PG8_BAR;
  PG8_STAGE(PG8_SB(1, 0), cB + kstep, voffB); PG8_STAGE(PG8_SA(1, 0), cA + kstep, voffA); PG8_STAGE(PG8_SB(1, 1), cB + hstep + kstep, voffB);
  PG8_WAIT_V(6); PG8_BAR;
  for (;;) {
    const bool has_next = S.next(ui + 1, nxt);
    const char* nA = has_next ? S.aptr(nxt) : cA; const char* nB = has_next ? S.bptr(nxt) : cB;
    const int nt = S.nt(cur);
    for (int t = 0; t < nt; t += 2) {
      const bool last = (t == nt - 2);
      const char* a1 = cA + (size_t)(t + 1) * kstep;
      const char* a2 = last ? nA : cA + (size_t)(t + 2) * kstep; const char* b2 = last ? nB : cB + (size_t)(t + 2) * kstep;
      const char* a3 = a2 + kstep; const char* b3 = b2 + kstep;
      PG8_LDB(B0, 0, 0); PG8_SCHED; PG8_LDA(At, 0, 0); PG8_STAGE(PG8_SA(1, 1), a1 + hstep, voffA);
      PG8_WAIT_L(8); PG8_BAR; PG8_WAIT_L(0); PG8_MMA(0, 0, At, B0); PG8_BAR; PG8_SCHED;
      PG8_LDB(B1, 0, 1); PG8_STAGE(PG8_SB(0, 0), b2, voffB);
      PG8_BAR; PG8_WAIT_L(0); PG8_MMA(0, 1, At, B1); PG8_BAR;
      PG8_LDA(At, 0, 1); PG8_STAGE(PG8_SA(0, 0), a2, voffA);
      PG8_BAR; PG8_WAIT_L(0); PG8_MMA(1, 0, At, B0); PG8_BAR; PG8_SCHED;
      PG8_STAGE(PG8_SB(0, 1), b2 + hstep, voffB);
      PG8_WAIT_V(6); PG8_BAR; PG8_MMA(1, 1, At, B1); PG8_BAR;
      PG8_LDB(B0, 1, 0); PG8_SCHED; PG8_LDA(At, 1, 0); PG8_STAGE(PG8_SA(0, 1), a2 + hstep, voffA);
      PG8_WAIT_L(8); PG8_BAR; PG8_WAIT_L(0); PG8_MMA(0, 0, At, B0); PG8_BAR; PG8_SCHED;
      PG8_LDB(B1, 1, 1); PG8_STAGE(PG8_SB(1, 0), b3, voffB);
      PG8_BAR; PG8_WAIT_L(0); PG8_MMA(0, 1, At, B1); PG8_BAR;
      PG8_LDA(At, 1, 1); PG8_STAGE(PG8_SA(1, 0), a3, voffA);
      PG8_BAR; PG8_WAIT_L(0); PG8_MMA(1, 0, At, B0); PG8_BAR; PG8_SCHED;
      PG8_STAGE(PG8_SB(1, 1), b3 + hstep, voffB);
      PG8_WAIT_V(6); PG8_BAR; PG8_MMA(1, 1, At, B1); PG8_BAR;
    }
    E(acc, cur, wr, wc, fr, fq);
    if (!has_next) break;
#pragma unroll
    for (int a = 0; a < 2; ++a)
#pragma unroll
      for (int b = 0; b < 2; ++b)
#pragma unroll
        for (int m = 0; m < 4; ++m)
#pragma unroll
          for (int n = 0; n < 2; ++n) acc[a][b][m][n] = (f32x4){0.f, 0.f, 0.f, 0.f};
    cur = nxt; cA = nA; cB = nB; ++ui;
  }
  PG8_WAIT_V(0);
  if (wr == 0) PG8_BAR;
  PG8_BAR;
#undef PG8_SA
#undef PG8_SB
#undef PG8_STAGE
#undef PG8_LDA
#undef PG8_LDB
#undef PG8_MMA
#undef PG8_WAIT_V
#undef PG8_WAIT_L
#undef PG8_BAR
#undef PG8_SCHED
}

#define EPI_LOOP(...) \
  _Pragma("unroll") for (int ai = 0; ai < 2; ++ai) _Pragma("unroll") for (int m = 0; m < 4; ++m) { const int row = u.pm * 256 + ai * 128 + wr * 64 + m * 16 + fr; \
    _Pragma("unroll") for (int bj = 0; bj < 2; ++bj) { const int col = u.pn * 256 + bj * 128 + wc * 32 + 8 * fq; const f32x4 v0 = acc[ai][bj][m][0], v1 = acc[ai][bj][m][1]; __VA_ARGS__ } }

struct EpiF32 {
  bf16_t* C; int ldc; float* part;
  DI void operator()(const f32x4 (&acc)[2][2][4][2], const Unit& u, int wr, int wc, int fr, int fq) const {
    if (u.g == 2) { EPI_LOOP({ float* d = part + ((size_t)u.kp * 512 + (row - TP)) * 1024 + col; *(f32x4*)d = v0; *(f32x4*)(d + 4) = v1; }) }
    else { EPI_LOOP({ *(u32x4*)(C + (size_t)row * ldc + col) = pk8(v0, v1); }) }
  }
};
struct EpiBf16 {
  bf16_t* O; int ldc; float scale; float* part;
  DI void operator()(const f32x4 (&acc)[2][2][4][2], const Unit& u, int wr, int wc, int fr, int fq) const {
    if (u.g == 2) { EPI_LOOP({ float* d = part + ((size_t)u.kp * 512 + (row - TP)) * 1024 + col; *(f32x4*)d = v0; *(f32x4*)(d + 4) = v1; }) }
    else { EPI_LOOP({ *(u32x4*)(O + (size_t)row * ldc + col) = pk8(v0 * scale, v1 * scale); }) }
  }
};
struct EpiP1 {
  bf16_t* proj; float* mk; float* mv; bf16_t* mkb; bf16_t* mvt;
  DI void operator()(const f32x4 (&acc)[2][2][4][2], const Unit& u, int wr, int wc, int fr, int fq) const {
    if (u.g == 0) {
      EPI_LOOP({ *(u32x4*)(proj + (size_t)row * NINP + col) = pk8(v0, v1); })
    } else if (u.pn < 4) {
      EPI_LOOP({ float* d = mk + (size_t)row * D + col; *(f32x4*)d = v0; *(f32x4*)(d + 4) = v1; *(u32x4*)(mkb + (size_t)row * D + col) = pk8(v0, v1); })
    } else {
      EPI_LOOP({ const int c2 = col - 1024; float* d = mv + (size_t)row * D + c2; *(f32x4*)d = v0; *(f32x4*)(d + 4) = v1;
                 const int b = row >> 8, key = row & 255, hh = c2 >> 8, dd = c2 & 255;
                 bf16_t* dst = mvt + ((size_t)((b * 4 + hh) * 256 + dd)) * 256 + key;
                 dst[0] = f2bf(v0[0]); dst[256] = f2bf(v0[1]); dst[512] = f2bf(v0[2]); dst[768] = f2bf(v0[3]);
                 dst[1024] = f2bf(v1[0]); dst[1280] = f2bf(v1[1]); dst[1536] = f2bf(v1[2]); dst[1792] = f2bf(v1[3]); })
    }
  }
};
struct EpiGU {
  bf16_t* act;
  DI void operator()(const f32x4 (&acc)[2][2][4][2], const Unit& u, int wr, int wc, int fr, int fq) const {
#pragma unroll
    for (int ai = 0; ai < 2; ++ai)
#pragma unroll
      for (int m = 0; m < 4; ++m) { const int row = u.pm * 256 + ai * 128 + wr * 64 + m * 16 + fr, col = u.pn * 128 + wc * 32 + 8 * fq;
        f32x4 o0, o1;
#pragma unroll
        for (int j = 0; j < 4; ++j) { o0[j] = siluf(acc[ai][0][m][0][j]) * acc[ai][1][m][0][j]; o1[j] = siluf(acc[ai][0][m][1][j]) * acc[ai][1][m][1][j]; }
        *(u32x4*)(act + (size_t)row * DFF + col) = pk8(o0, o1); }
  }
};
}

DI const float* prep_row_src(const Params& p, int r) { return r < TP ? p.in[0] + (size_t)r * D : (r < T ? p.in[1] + (size_t)(r - TP) * D : p.in[2] + (size_t)(r - T) * D); }
DI void rownorm_store(const f32x4 (&v)[4], const float* w, bf16_t* o, int lane) {
  float ss = 0.f;
#pragma unroll
  for (int e = 0; e < 4; ++e) ss += v[e][0] * v[e][0] + v[e][1] * v[e][1] + v[e][2] * v[e][2] + v[e][3] * v[e][3];
  ss = wave_sum(ss); const float rstd = rsqrtf(ss * (1.f / 1024.f) + EPS);
#pragma unroll
  for (int i = 0; i < 2; ++i) { const f32x4 w0 = *(const f32x4*)(w + RCOL(2 * i)), w1 = *(const f32x4*)(w + RCOL(2 * i + 1));
    *(u32x4*)(o + i * 512 + lane * 8) = pk8(v[2 * i] * rstd * w0, v[2 * i + 1] * rstd * w1); }
}
DI void tr_weight(const float* W, bf16_t* Wt, const int K, const int N, const int ntn, const int drow_off, const int gu, const int rot, ldsp lds, int tid, const int G, const int lb) {
  LAS float* tile = (LAS float*)lds;
  const int nn = tid & 63, kb = tid >> 6, n2 = tid >> 3, kq = tid & 7;
  const int ktiles = K / 64, ntiles = ntn * ktiles;
  int task = (lb + G - (rot % G)) % G;
  float pre[8];
  if (task < ntiles) { const int n = (task / ktiles) * 64 + nn, k0 = (task % ktiles) * 64;
#pragma unroll
    for (int i = 0; i < 8; ++i) pre[i] = (n < N) ? W[(size_t)(k0 + kb + 8 * i) * N + n] : 0.f; }
  while (task < ntiles) {
#pragma unroll
    for (int i = 0; i < 8; ++i) tile[(kb + 8 * i) * 65 + nn] = pre[i];
    const int n0 = (task / ktiles) * 64, k0 = (task % ktiles) * 64;
    const int nxt = task + G;
    if (nxt < ntiles) { const int n = (nxt / ktiles) * 64 + nn, k1 = (nxt % ktiles) * 64;
#pragma unroll
      for (int i = 0; i < 8; ++i) pre[i] = (n < N) ? W[(size_t)(k1 + kb + 8 * i) * N + n] : 0.f; }
    lbar();
    float v[8];
#pragma unroll
    for (int j = 0; j < 8; ++j) v[j] = tile[(kq * 8 + j) * 65 + n2];
    u32x4 w; w.x = pk2(v[0], v[1]); w.y = pk2(v[2], v[3]); w.z = pk2(v[4], v[5]); w.w = pk2(v[6], v[7]);
    const int drow0 = gu ? (n0 >> 7) * 256 + (gu - 1) * 128 + (n0 & 127) : n0 + drow_off;
    *(u32x4*)(Wt + (size_t)(drow0 + n2) * K + k0 + kq * 8) = w;
    lbar();
    task = nxt;
  }
}
DI void phase_prep(const Params& p, ldsp lds, int tid_) {
  int tid = tid_; asm volatile("" : "+v"(tid));
  const int G = gridDim.x, wid = tid >> 6, lane = tid & 63;
  unsigned char* ws = p.ws;
  tr_weight(p.in[10], (bf16_t*)(ws + W_IN), 1024, NIN, 52, 0, 0, 0, lds, tid, G, (int)blockIdx.x);
  tr_weight(p.in[25], (bf16_t*)(ws + W_KV), 1024, 1024, 16, 0, 0, 832, lds, tid, G, (int)blockIdx.x);
  tr_weight(p.in[26], (bf16_t*)(ws + W_KV), 1024, 1024, 16, 1024, 0, 1088, lds, tid, G, (int)blockIdx.x);
  {
    const int wv = blockIdx.x * 8 + wid, nwv = G * 8, NR = T + 2048;
    f32x4 v0[4], v1[4];
    const int r1 = wv + nwv;
    if (wv < NR) {
#pragma unroll
      for (int i = 0; i < 4; ++i) v0[i] = *(const f32x4*)(prep_row_src(p, wv) + RCOL(i)); }
    if (r1 < NR) {
#pragma unroll
      for (int i = 0; i < 4; ++i) v1[i] = *(const f32x4*)(prep_row_src(p, r1) + RCOL(i)); }
    for (int r = wv; r < NR; r += nwv) {
      const int rn = r + 2 * nwv; f32x4 v2[4];
      const int rc = rn < NR ? rn : r;
#pragma unroll
      for (int i = 0; i < 4; ++i) v2[i] = *(const f32x4*)(prep_row_src(p, rc) + RCOL(i));
      if (r < T) rownorm_store(v0, p.in[8], (bf16_t*)(ws + B_XA) + (size_t)r * D, lane);
      else rownorm_store(v0, p.in[23], (bf16_t*)(ws + B_MN) + (size_t)(r - T) * D, lane);
#pragma unroll
      for (int i = 0; i < 4; ++i) { v0[i] = v1[i]; v1[i] = v2[i]; }
    }
  }
}

DI u32x4 ld16(const bf16_t* p) { return *(const u32x4*)p; }
#define Z4 ((u32x4){0u, 0u, 0u, 0u})

DI void precompute_item(const Params& p, int item, ldsp lds, int tid_) {
  int tid = tid_; asm volatile("" : "+v"(tid));
  const int wid = __builtin_amdgcn_readfirstlane(tid >> 6), lane = tid & 63;
  const bf16_t* proj = (const bf16_t*)(p.ws + B_PROJ);
  const bool sample = item >= 256;
  const int bs = item - 256, c = item & 31;
  const int r0 = sample ? TP + bs * 4 : (item >> 5) * 2048 + c * 64, ntok = sample ? 4 : 64;
  ldsp W2L = lds, GL = lds + 16384, QR = lds + 20480, KR = lds + 53248, BT = lds + 86016;
#pragma unroll
  for (int i = 0; i < 4; ++i) { const int idx = tid + 512 * i, t = idx >> 5, pc = idx & 31; const bool ok = t < ntok; const bf16_t* sp = proj + (size_t)(r0 + t) * NINP + pc * 8;
    *(LAS u32x4*)(QR + t * 512 + pc * 16) = ok ? ld16(sp + C_Q) : Z4; *(LAS u32x4*)(KR + t * 512 + pc * 16) = ok ? ld16(sp + C_K) : Z4; }
  if (tid < 128) { const int t2 = tid >> 1, p2 = tid & 1; const u32x4 rg = (t2 < ntok) ? ld16(proj + (size_t)(r0 + t2) * NINP + C_GLR + p2 * 8) : Z4;
    *(LAS f32x4*)(GL + (t2 * 16 + p2 * 8) * 4) = (f32x4){bflo(rg.x), bfhi(rg.x), bflo(rg.y), bfhi(rg.y)}; *(LAS f32x4*)(GL + (t2 * 16 + p2 * 8 + 4) * 4) = (f32x4){bflo(rg.z), bfhi(rg.z), bflo(rg.w), bfhi(rg.w)}; }
  {
    const int ch = 2 * tid;
    float cw[4][2], cb[2];
#pragma unroll
    for (int j = 0; j < 4; ++j) { const f32x2 w = *(const f32x2*)(p.in[14] + j * 1024 + ch); cw[j][0] = w[0]; cw[j][1] = w[1]; }
    { const f32x2 w = *(const f32x2*)(p.in[15] + ch); cb[0] = w[0]; cb[1] = w[1]; }
    unsigned x0 = 0u, x1 = 0u, x2 = 0u;
    if (sample) { const float* sp = p.in[5] + (size_t)bs * 3072 + ch; const f32x2 a0 = *(const f32x2*)sp, a1 = *(const f32x2*)(sp + 1024), a2 = *(const f32x2*)(sp + 2048);
      x0 = pk2(a0[0], a0[1]); x1 = pk2(a1[0], a1[1]); x2 = pk2(a2[0], a2[1]); }
    else if (c > 0) { const bf16_t* sp = proj + (size_t)(r0 - 3) * NINP + C_XBC + ch; x0 = *(const unsigned*)sp; x1 = *(const unsigned*)(sp + NINP); x2 = *(const unsigned*)(sp + 2 * NINP); }
    unsigned* xact = (unsigned*)((bf16_t*)(p.ws + B_XACT) + (size_t)r0 * D + ch);
    const int nb = sample ? 1 : 4;
#pragma unroll 1
    for (int tb = 0; tb < nb; ++tb) {
      unsigned xr[16];
#pragma unroll
      for (int i = 0; i < 16; ++i) { const int t = tb * 16 + i; xr[i] = (t < ntok) ? *(const unsigned*)(proj + (size_t)(r0 + t) * NINP + C_XBC + ch) : 0u; }
#pragma unroll
      for (int i = 0; i < 16; ++i) { const int t = tb * 16 + i; const unsigned x3 = xr[i];
        const float a0 = cb[0] + cw[0][0] * bflo(x0) + cw[1][0] * bflo(x1) + cw[2][0] * bflo(x2) + cw[3][0] * bflo(x3);
        const float a1 = cb[1] + cw[0][1] * bfhi(x0) + cw[1][1] * bfhi(x1) + cw[2][1] * bfhi(x2) + cw[3][1] * bfhi(x3);
        if (t < ntok) xact[(size_t)t * (D / 2)] = pk2(siluf(a0), siluf(a1));
        x0 = x1; x1 = x2; x2 = x3; }
    }
  }
  { const float dtb = p.in[16][wid], aneg = -__expf(p.in[17][wid]);
    const float raw = (lane < ntok) ? bf2f(proj[(size_t)(r0 + lane) * NINP + C_DT + wid]) : 0.f;
    const float dtv = (lane < ntok) ? softplusf(raw + dtb) : 0.f;
    float x = dtv * aneg;
#pragma unroll
    for (int o = 1; o < 64; o <<= 1) { const float y = __shfl_up(x, o); if (lane >= o) x += y; }
    if (lane < ntok) { ((float*)(p.ws + B_DT))[(size_t)(r0 + lane) * 8 + wid] = dtv; ((float*)(p.ws + B_LC))[(size_t)(r0 + lane) * 8 + wid] = x; } }
  __syncthreads();
  float pre[4][8];
#pragma unroll
  for (int hh = 0; hh < 4; ++hh) { const int col = hh * 64 + lane; float w2[16];
#pragma unroll
    for (int r = 0; r < 16; ++r) w2[r] = *(const LAS float*)(W2L + (r * 256 + col) * 4);
    const float gbias = p.in[12][col]; float run = 0.f;
#pragma unroll
    for (int i = 0; i < 8; ++i) { const int t = wid * 8 + i; float x = gbias;
#pragma unroll
      for (int r4 = 0; r4 < 4; ++r4) { const f32x4 gv = *(const LAS f32x4*)(GL + (t * 16 + r4 * 4) * 4); x += gv[0] * w2[r4 * 4] + gv[1] * w2[r4 * 4 + 1] + gv[2] * w2[r4 * 4 + 2] + gv[3] * w2[r4 * 4 + 3]; }
      const float lf = (t < ntok) ? -softplusf(-x) * (1.f / 16.f) : 0.f; run += lf; pre[hh][i] = run; }
    *(LAS float*)(BT + (wid * 256 + col) * 4) = run; }
  __syncthreads();
  bf16_t* qtg = (bf16_t*)(p.ws + B_QT); bf16_t* ktg = (bf16_t*)(p.ws + B_KT);
#pragma unroll
  for (int hh = 0; hh < 4; ++hh) { const int col = hh * 64 + lane; float off = 0.f, tot = 0.f;
#pragma unroll
    for (int j = 0; j < 8; ++j) { const float v = *(const LAS float*)(BT + (j * 256 + col) * 4); tot += v; if (j < wid) off += v; }
#pragma unroll
    for (int i = 0; i < 8; ++i) { const int t = wid * 8 + i; const float bi = off + pre[hh][i];
      const float q = bf2f(*(const LAS bf16_t*)(QR + t * 512 + col * 2)), k = bf2f(*(const LAS bf16_t*)(KR + t * 512 + col * 2));
      if (t < ntok) { const size_t o = (size_t)(r0 + t) * 256 + col;
        qtg[o] = f2bf(q * 0.125f * __expf(bi)); ktg[o] = f2bf(k * __expf(-bi)); } }
    if (wid == 0) ((float*)(p.ws + B_EB))[(size_t)item * 256 + col] = __expf(tot); }
  __syncthreads();
}
DI void phase_precompute(const Params& p, ldsp lds, int tid) {
  for (int i = tid; i < 4096; i += 512) *(LAS float*)(lds + i * 4) = p.in[11][i];
  __syncthreads();
  for (int item = blockIdx.x; item < 384; item += gridDim.x) precompute_item(p, item, lds, tid);
}

DI void gla_chain(const Params& p, int b, int h, bool sample, ldsp lds, int tid_) {
  int tid = tid_; asm volatile("" : "+v"(tid));
  const int wid = __builtin_amdgcn_readfirstlane(tid >> 6), lane = tid & 63, fr = lane & 15, fq = lane >> 4;
  const bf16_t* proj = (const bf16_t*)(p.ws + B_PROJ);
  const bf16_t* qtg = (const bf16_t*)(p.ws + B_QT); const bf16_t* ktg = (const bf16_t*)(p.ws + B_KT);
  const float* ebg = (const float*)(p.ws + B_EB);
  bf16_t* oraw = (bf16_t*)(p.ws + B_GOUT);
  const int nchunks = sample ? 1 : 32, ntok = sample ? 4 : 64, rowbase = sample ? TP + b * 4 : b * 2048, item0 = sample ? 256 + b : b * 32;
  ldsp VV = lds, QT = lds + 17408, KT = lds + 26624, KD = lds + 35840, ATT = lds + 45056, SB = lds + 54272, EB = lds + 71680;
  f32x4 Sacc[4];
  float* sout = p.out + (sample ? O_GLAS : O_GLAP) + (size_t)(b * 4 + h) * 8192;
#pragma unroll
  for (int kt = 0; kt < 4; ++kt) {
    if (sample) Sacc[kt] = *(const f32x4*)(p.in[3] + (size_t)(b * 4 + h) * 8192 + (kt * 16 + fr) * 128 + wid * 16 + 4 * fq);
    else Sacc[kt] = (f32x4){0.f, 0.f, 0.f, 0.f};
    u32x2 w; w.x = pk2(Sacc[kt][0], Sacc[kt][1]); w.y = pk2(Sacc[kt][2], Sacc[kt][3]);
    *(LAS u32x2*)(SB + (kt * 16 + fr) * 272 + (wid * 16 + 4 * fq) * 2) = w;
  }
  u32x4 rq = Z4, rk = Z4, rv0 = Z4, rv1 = Z4; float reb = 0.f;
  const int tq_ = tid >> 3, pq_ = tid & 7;
#define GLA_LOAD(c) do { const int r0 = rowbase + (c) * 64; \
    { const bool ok = tq_ < ntok; const size_t o = (size_t)(r0 + tq_) * 256 + h * 64 + pq_ * 8; rq = ok ? ld16(qtg + o) : Z4; rk = ok ? ld16(ktg + o) : Z4; } \
    { const int t0 = tid >> 4, p0 = tid & 15; rv0 = (t0 < ntok) ? ld16(proj + (size_t)(r0 + t0) * NINP + C_V + h * 128 + p0 * 8) : Z4; \
      const int t1 = (tid + 512) >> 4; rv1 = (t1 < ntok) ? ld16(proj + (size_t)(r0 + t1) * NINP + C_V + h * 128 + p0 * 8) : Z4; } \
    if (tid < 64) reb = ebg[(size_t)(item0 + (c)) * 256 + h * 64 + tid]; } while (0)
  GLA_LOAD(0);
  for (int c = 0; c < nchunks; ++c) {
    *(LAS u32x4*)(QT + tq_ * 144 + pq_ * 16) = rq; *(LAS u32x4*)(KT + tq_ * 144 + pq_ * 16) = rk;
    *(LAS u32x4*)(VV + (tid >> 4) * 272 + (tid & 15) * 16) = rv0; *(LAS u32x4*)(VV + ((tid + 512) >> 4) * 272 + (tid & 15) * 16) = rv1;
    if (tid < 64) *(LAS float*)(EB + tid * 4) = reb;
    if (c + 1 < nchunks) GLA_LOAD(c + 1);
    lbar();
    f32x4 oacc[4];
    { const int tt = wid >> 1;
#pragma unroll
      for (int u = 0; u < 2; ++u) { const int st = (wid & 1) * 2 + u; f32x4 a = {0.f, 0.f, 0.f, 0.f};
        if (st <= tt) {
#pragma unroll
          for (int ks = 0; ks < 2; ++ks) a = mma16(ldfrag(KT, 144, st * 16, ks * 32, lane), ldfrag(QT, 144, tt * 16, ks * 32, lane), a);
          const int t = tt * 16 + fr, s0 = st * 16 + 4 * fq;
#pragma unroll
          for (int j = 0; j < 4; ++j) if (s0 + j > t) a[j] = 0.f;
        }
        u32x2 w; w.x = pk2(a[0], a[1]); w.y = pk2(a[2], a[3]);
        *(LAS u32x2*)(ATT + (tt * 16 + fr) * 144 + (st * 16 + 4 * fq) * 2) = w; }
      bf16x8 sf[2];
#pragma unroll
      for (int ks = 0; ks < 2; ++ks) sf[ks] = ldfrag_tr(SB, 272, ks * 32, wid * 16, lane);
#pragma unroll
      for (int t4 = 0; t4 < 4; ++t4) { oacc[t4] = (f32x4){0.f, 0.f, 0.f, 0.f};
#pragma unroll
        for (int ks = 0; ks < 2; ++ks) oacc[t4] = mma16(sf[ks], ldfrag(QT, 144, t4 * 16, ks * 32, lane), oacc[t4]); } }
    lbar();
    { bf16x8 vf[2];
#pragma unroll
      for (int ks = 0; ks < 2; ++ks) vf[ks] = ldfrag_tr(VV, 272, ks * 32, wid * 16, lane);
#pragma unroll
      for (int t4 = 0; t4 < 4; ++t4) {
#pragma unroll
        for (int ks = 0; ks < 2; ++ks) if (ks * 2 <= t4) oacc[t4] = mma16(vf[ks], ldfrag(ATT, 144, t4 * 16, ks * 32, lane), oacc[t4]);
        const int t = t4 * 16 + fr;
        if (t < ntok) *(u32x2*)(oraw + (size_t)(rowbase + c * 64 + t) * D + h * 128 + wid * 16 + 4 * fq) = pk4(oacc[t4]); }
#pragma unroll
      for (int kt = 0; kt < 4; ++kt) { const float eb = *(const LAS float*)(EB + (kt * 16 + fr) * 4);
#pragma unroll
        for (int ks = 0; ks < 2; ++ks) Sacc[kt] = mma16(vf[ks], ldfrag_tr(KT, 144, ks * 32, kt * 16, lane), Sacc[kt]);
        Sacc[kt] *= eb;
        u32x2 w; w.x = pk2(Sacc[kt][0], Sacc[kt][1]); w.y = pk2(Sacc[kt][2], Sacc[kt][3]);
        *(LAS u32x2*)(SB + (kt * 16 + fr) * 272 + (wid * 16 + 4 * fq) * 2) = w; } }
    lbar();
  }
#undef GLA_LOAD
#pragma unroll
  for (int kt = 0; kt < 4; ++kt) *(f32x4*)(sout + (kt * 16 + fr) * 128 + wid * 16 + 4 * fq) = Sacc[kt];
}

DI void ssd_step(ldsp lds, int c, int wid, int lane, int tid, int ntok, int rowbase, int h, float Dh, bf16_t* oraw, f32x4 (&Sacc)[4]) {
  const int fr = lane & 15, fq = lane >> 4;
  ldsp MM = lds, XW = lds + 9216, SB = lds + 18432;
  ldsp IB = lds + 35840 + (c & 1) * 53248;
  ldsp XS = IB, ZR = IB + 9216, BMI = IB + 17408, CMI = IB + 34816, DTs = IB + 52224, LC = IB + 52480;
  const float ll = *(const LAS float*)(LC + 63 * 4);
  f32x4 y2[2];
  { const int tt = wid >> 1;
    const float lct = *(const LAS float*)(LC + (tt * 16 + fr) * 4);
    bf16x8 cf[4];
#pragma unroll
    for (int ks = 0; ks < 4; ++ks) cf[ks] = ldfrag(CMI, 272, tt * 16, ks * 32, lane);
    { const int s = tid >> 3, p0 = (tid & 7) * 8; const float wgt = __expf(ll - *(const LAS float*)(LC + s * 4)) * *(const LAS float*)(DTs + s * 4);
      const u32x4 xv = *(const LAS u32x4*)(XS + s * 144 + p0 * 2); u32x4 o;
      o.x = pk2(bflo(xv.x) * wgt, bfhi(xv.x) * wgt); o.y = pk2(bflo(xv.y) * wgt, bfhi(xv.y) * wgt); o.z = pk2(bflo(xv.z) * wgt, bfhi(xv.z) * wgt); o.w = pk2(bflo(xv.w) * wgt, bfhi(xv.w) * wgt);
      *(LAS u32x4*)(XW + s * 144 + p0 * 2) = o; }
#pragma unroll
    for (int u = 0; u < 2; ++u) { const int st = (wid & 1) * 2 + u; f32x4 a = {0.f, 0.f, 0.f, 0.f};
      if (st <= tt) {
#pragma unroll
        for (int ks = 0; ks < 4; ++ks) a = mma16(ldfrag(BMI, 272, st * 16, ks * 32, lane), cf[ks], a);
        const int t = tt * 16 + fr, s0 = st * 16 + 4 * fq;
        const f32x4 lcs = *(const LAS f32x4*)(LC + s0 * 4), dts = *(const LAS f32x4*)(DTs + s0 * 4);
#pragma unroll
        for (int j = 0; j < 4; ++j) a[j] = (s0 + j <= t) ? a[j] * __expf(lct - lcs[j]) * dts[j] : 0.f;
      }
      u32x2 w; w.x = pk2(a[0], a[1]); w.y = pk2(a[2], a[3]);
      *(LAS u32x2*)(MM + (tt * 16 + fr) * 144 + (st * 16 + 4 * fq) * 2) = w; }
#pragma unroll
    for (int u = 0; u < 2; ++u) { const int pt = (wid & 1) * 2 + u; y2[u] = (f32x4){0.f, 0.f, 0.f, 0.f};
#pragma unroll
      for (int ks = 0; ks < 4; ++ks) y2[u] = mma16(ldfrag(SB, 272, pt * 16, ks * 32, lane), cf[ks], y2[u]); } }
  lbar();
  { const int tt = wid >> 1, t = tt * 16 + fr;
    const float elc = __expf(*(const LAS float*)(LC + t * 4));
    bf16x8 mf[2];
#pragma unroll
    for (int ks = 0; ks < 2; ++ks) mf[ks] = ldfrag(MM, 144, tt * 16, ks * 32, lane);
#pragma unroll
    for (int u = 0; u < 2; ++u) { const int pt = (wid & 1) * 2 + u; f32x4 y1 = {0.f, 0.f, 0.f, 0.f};
#pragma unroll
      for (int ks = 0; ks < 2; ++ks) if (ks * 2 <= tt) y1 = mma16(ldfrag_tr(XS, 144, ks * 32, pt * 16, lane), mf[ks], y1);
      const int p0 = pt * 16 + 4 * fq;
      const u32x2 xv = *(const LAS u32x2*)(XS + t * 144 + p0 * 2), zv = *(const LAS u32x2*)(ZR + t * 128 + p0 * 2);
      const float xs4[4] = {bflo(xv.x), bfhi(xv.x), bflo(xv.y), bfhi(xv.y)}, z4[4] = {bflo(zv.x), bfhi(zv.x), bflo(zv.y), bfhi(zv.y)};
      f32x4 y;
#pragma unroll
      for (int j = 0; j < 4; ++j) y[j] = (y1[j] + elc * y2[u][j] + Dh * xs4[j]) * siluf(z4[j]);
      if (t < ntok) *(u32x2*)(oraw + (size_t)(rowbase + c * 64 + t) * D + 512 + h * 64 + p0) = pk4(y); }
    const float ell = __expf(ll);
    bf16x8 bf_[2];
#pragma unroll
    for (int ks = 0; ks < 2; ++ks) bf_[ks] = ldfrag_tr(BMI, 272, ks * 32, wid * 16, lane);
#pragma unroll
    for (int pt = 0; pt < 4; ++pt) { Sacc[pt] *= ell;
#pragma unroll
      for (int ks = 0; ks < 2; ++ks) Sacc[pt] = mma16(bf_[ks], ldfrag_tr(XW, 144, ks * 32, pt * 16, lane), Sacc[pt]);
      u32x2 w; w.x = pk2(Sacc[pt][0], Sacc[pt][1]); w.y = pk2(Sacc[pt][2], Sacc[pt][3]);
      *(LAS u32x2*)(SB + (pt * 16 + fr) * 272 + (wid * 16 + 4 * fq) * 2) = w; } }
}

DI void ssd_chain(const Params& p, int b, int h, bool sample, ldsp lds, int tid_) {
  int tid = tid_; asm volatile("" : "+v"(tid));
  const int wid = __builtin_amdgcn_readfirstlane(tid >> 6), lane = tid & 63, fr = lane & 15, fq = lane >> 4;
  const bf16_t* proj = (const bf16_t*)(p.ws + B_PROJ);
  const bf16_t* xact = (const bf16_t*)(p.ws + B_XACT);
  const float* dtg = (const float*)(p.ws + B_DT); const float* lcg = (const float*)(p.ws + B_LC);
  bf16_t* oraw = (bf16_t*)(p.ws + B_GOUT);
  const int nchunks = sample ? 1 : 32, ntok = sample ? 4 : 64, rowbase = sample ? TP + b * 4 : b * 2048, g = h >> 2;
  ldsp MM = lds, XW = lds + 9216, SB = lds + 18432;
  const float Dh = p.in[18][h];
  f32x4 Sacc[4];
  float* sout = p.out + (sample ? O_SSMS : O_SSMP) + (size_t)(b * 8 + h) * 8192;
#pragma unroll
  for (int pt = 0; pt < 4; ++pt) {
    if (sample) Sacc[pt] = *(const f32x4*)(p.in[4] + (size_t)(b * 8 + h) * 8192 + (pt * 16 + fr) * 128 + wid * 16 + 4 * fq);
    else Sacc[pt] = (f32x4){0.f, 0.f, 0.f, 0.f};
    u32x2 w; w.x = pk2(Sacc[pt][0], Sacc[pt][1]); w.y = pk2(Sacc[pt][2], Sacc[pt][3]);
    *(LAS u32x2*)(SB + (pt * 16 + fr) * 272 + (wid * 16 + 4 * fq) * 2) = w;
  }
  u32x4 rxA = Z4, rzA = Z4, rb0A = Z4, rb1A = Z4, rc0A = Z4, rc1A = Z4; float rdtA = 0.f, rlcA = 0.f;
  u32x4 rxB = Z4, rzB = Z4, rb0B = Z4, rb1B = Z4, rc0B = Z4, rc1B = Z4; float rdtB = 0.f, rlcB = 0.f;
  const int tq_ = tid >> 3, pq_ = tid & 7;
#define SSD_LOAD(c, S) do { const int r0 = rowbase + (c) * 64; \
    { const bool ok = tq_ < ntok; rx##S = ok ? ld16(xact + (size_t)(r0 + tq_) * D + h * 64 + pq_ * 8) : Z4; rz##S = ok ? ld16(proj + (size_t)(r0 + tq_) * NINP + C_Z + h * 64 + pq_ * 8) : Z4; } \
    { const int t0 = tid >> 4, p0 = tid & 15, t1 = (tid + 512) >> 4; const bf16_t* s0 = xact + (size_t)(r0 + t0) * D + 512 + g * 128 + p0 * 8; const bf16_t* s1 = xact + (size_t)(r0 + t1) * D + 512 + g * 128 + p0 * 8; \
      rb0##S = (t0 < ntok) ? ld16(s0) : Z4; rc0##S = (t0 < ntok) ? ld16(s0 + 256) : Z4; rb1##S = (t1 < ntok) ? ld16(s1) : Z4; rc1##S = (t1 < ntok) ? ld16(s1 + 256) : Z4; } \
    if (tid < 64) { const int tc = tid < ntok ? tid : ntok - 1; rdt##S = (tid < ntok) ? dtg[(size_t)(r0 + tid) * 8 + h] : 0.f; rlc##S = lcg[(size_t)(r0 + tc) * 8 + h]; } } while (0)
#define SSD_WRITE(bufi, S) do { ldsp NB_ = lds + 35840 + (bufi) * 53248; \
    *(LAS u32x4*)(NB_ + tq_ * 144 + pq_ * 16) = rx##S; *(LAS u32x4*)(NB_ + 9216 + tq_ * 128 + pq_ * 16) = rz##S; \
    *(LAS u32x4*)(NB_ + 17408 + (tid >> 4) * 272 + (tid & 15) * 16) = rb0##S; *(LAS u32x4*)(NB_ + 17408 + ((tid + 512) >> 4) * 272 + (tid & 15) * 16) = rb1##S; \
    *(LAS u32x4*)(NB_ + 34816 + (tid >> 4) * 272 + (tid & 15) * 16) = rc0##S; *(LAS u32x4*)(NB_ + 34816 + ((tid + 512) >> 4) * 272 + (tid & 15) * 16) = rc1##S; \
    if (tid < 64) { *(LAS float*)(NB_ + 52224 + tid * 4) = rdt##S; *(LAS float*)(NB_ + 52480 + tid * 4) = rlc##S; } } while (0)
  SSD_LOAD(0, B);
  SSD_WRITE(0, B);
  if (nchunks > 1) SSD_LOAD(1, A);
  if (nchunks > 2) SSD_LOAD(2, B);
  lbar();
  for (int c = 0; c < nchunks; c += 2) {
    ssd_step(lds, c, wid, lane, tid, ntok, rowbase, h, Dh, oraw, Sacc);
    if (c + 1 < nchunks) { SSD_WRITE(1, A); if (c + 3 < nchunks) SSD_LOAD(c + 3, A); }
    lbar();
    if (c + 1 < nchunks) {
      ssd_step(lds, c + 1, wid, lane, tid, ntok, rowbase, h, Dh, oraw, Sacc);
      if (c + 2 < nchunks) { SSD_WRITE(0, B); if (c + 4 < nchunks) SSD_LOAD(c + 4, B); }
      lbar();
    }
  }
#undef SSD_WRITE
#undef SSD_LOAD
#pragma unroll
  for (int pt = 0; pt < 4; ++pt) *(f32x4*)(sout + (pt * 16 + fr) * 128 + wid * 16 + 4 * fq) = Sacc[pt];
}

#ifndef REP_CH
#define REP_CH 1
#endif
#ifndef REP_SM
#define REP_SM 1
#endif
DI void phase_mixer(const Params& p, ldsp lds, int tid) {
  const int G = gridDim.x, bid = blockIdx.x;
  for (int rc_ = 0; rc_ < REP_CH; ++rc_)
  for (int i = bid; i < 96; i += G) {
    if (i < 32) gla_chain(p, i >> 2, i & 3, false, lds, tid);
    else ssd_chain(p, (i - 32) >> 3, (i - 32) & 7, false, lds, tid);
    __syncthreads();
  }
  const int sw0 = G > 96 ? 96 : 0, nsw = G - sw0;
  if (bid >= sw0)
    for (int rs_ = 0; rs_ < REP_SM; ++rs_)
    for (int j = bid - sw0; j < 1536; j += nsw) {
      if (j < 512) gla_chain(p, j >> 2, j & 3, true, lds, tid);
      else ssd_chain(p, (j - 512) >> 3, (j - 512) & 7, true, lds, tid);
      __syncthreads();
    }
  if (bid >= sw0) {
    unsigned char* ws = p.ws; const int lb = bid - sw0;
    tr_weight(p.in[20], (bf16_t*)(ws + W_OUT), 1024, 1024, 16, 0, 0, 0, lds, tid, nsw, lb);
    tr_weight(p.in[24], (bf16_t*)(ws + W_XQ), 1024, 1024, 16, 0, 0, 256, lds, tid, nsw, lb);
    tr_weight(p.in[27], (bf16_t*)(ws + W_XO), 1024, 1024, 16, 0, 0, 512, lds, tid, nsw, lb);
    tr_weight(p.in[30], (bf16_t*)(ws + W_GU), 1024, DFF, 44, 0, 1, 768, lds, tid, nsw, lb);
    tr_weight(p.in[31], (bf16_t*)(ws + W_GU), 1024, DFF, 44, 0, 2, 1472, lds, tid, nsw, lb);
    tr_weight(p.in[32], (bf16_t*)(ws + W_DN), DFF, 1024, 16, 0, 0, 2176, lds, tid, nsw, lb);
  }
}

DI void mixnorm_row(const Params& p, int r, const f32x4 (&v)[4], const u32x4 gv, int lane) {
  bf16_t* xa = (bf16_t*)(p.ws + B_XA);
  { float ss = v[0][0] * v[0][0] + v[0][1] * v[0][1] + v[0][2] * v[0][2] + v[0][3] * v[0][3] + v[1][0] * v[1][0] + v[1][1] * v[1][1] + v[1][2] * v[1][2] + v[1][3] * v[1][3];
#pragma unroll
    for (int s = 8; s >= 1; s >>= 1) ss += __shfl_xor(ss, s);
    const float rstd = rsqrtf(ss * (1.f / 128.f) + EPS);
    const f32x4 w0 = *(const f32x4*)(p.in[13] + ((lane * 8) & 127)), w1 = *(const f32x4*)(p.in[13] + ((lane * 8) & 127) + 4);
    f32x4 o0, o1;
    o0[0] = v[0][0] * rstd * w0[0] * siluf(bflo(gv.x)); o0[1] = v[0][1] * rstd * w0[1] * siluf(bfhi(gv.x)); o0[2] = v[0][2] * rstd * w0[2] * siluf(bflo(gv.y)); o0[3] = v[0][3] * rstd * w0[3] * siluf(bfhi(gv.y));
    o1[0] = v[1][0] * rstd * w1[0] * siluf(bflo(gv.z)); o1[1] = v[1][1] * rstd * w1[1] * siluf(bfhi(gv.z)); o1[2] = v[1][2] * rstd * w1[2] * siluf(bflo(gv.w)); o1[3] = v[1][3] * rstd * w1[3] * siluf(bfhi(gv.w));
    *(u32x4*)(xa + (size_t)r * D + lane * 8) = pk8(o0, o1); }
  { float ss = v[2][0] * v[2][0] + v[2][1] * v[2][1] + v[2][2] * v[2][2] + v[2][3] * v[2][3] + v[3][0] * v[3][0] + v[3][1] * v[3][1] + v[3][2] * v[3][2] + v[3][3] * v[3][3];
#pragma unroll
    for (int s = 16; s >= 1; s >>= 1) ss += __shfl_xor(ss, s);
    const float rstd = rsqrtf(ss * (1.f / 256.f) + EPS);
    const f32x4 w0 = *(const f32x4*)(p.in[19] + lane * 8), w1 = *(const f32x4*)(p.in[19] + lane * 8 + 4);
    *(u32x4*)(xa + (size_t)r * D + 512 + lane * 8) = pk8(v[2] * rstd * w0, v[3] * rstd * w1); }
}
DI void phase_mixnorm(const Params& p, int tid_) {
  int tid = tid_; asm volatile("" : "+v"(tid));
  const int G = gridDim.x, wid = tid >> 6, lane = tid & 63;
  const bf16_t* proj = (const bf16_t*)(p.ws + B_PROJ);
  const bf16_t* oraw = (const bf16_t*)(p.ws + B_GOUT);
  const int wv = blockIdx.x * 8 + wid, nwv = G * 8;
  if (wv < T) {
    f32x4 v[4]; u32x4 gv;
    ld_row_bf16(oraw + (size_t)wv * D, v, lane);
    gv = *(const u32x4*)(proj + (size_t)wv * NINP + C_G + lane * 8);
    for (int r = wv; r < T; r += nwv) {
      const int rn = (r + nwv < T) ? r + nwv : r;
      f32x4 vn[4]; u32x4 gn;
      ld_row_bf16(oraw + (size_t)rn * D, vn, lane);
      gn = *(const u32x4*)(proj + (size_t)rn * NINP + C_G + lane * 8);
      mixnorm_row(p, r, v, gv, lane);
#pragma unroll
      for (int e = 0; e < 4; ++e) v[e] = vn[e];
      gv = gn;
    }
  }
  for (int q = wv; q < 408; q += nwv) {
    int srow; float* dst;
    if (q < 24) { const int b = q / 3, j = q % 3; srow = b * 2048 + 2045 + j; dst = p.out + O_CONVP + (size_t)q * 1024; }
    else { const int q2 = q - 24, b = q2 / 3, j = q2 % 3; srow = TP + b * 4 + 1 + j; dst = p.out + O_CONVS + (size_t)q2 * 1024; }
#pragma unroll
    for (int i = 0; i < 2; ++i) { const u32x4 xv = ld16(proj + (size_t)srow * NINP + C_XBC + i * 512 + lane * 8);
      *(f32x4*)(dst + i * 512 + lane * 8) = (f32x4){bflo(xv.x), bfhi(xv.x), bflo(xv.y), bfhi(xv.y)};
      *(f32x4*)(dst + i * 512 + lane * 8 + 4) = (f32x4){bflo(xv.z), bfhi(xv.z), bflo(xv.w), bfhi(xv.w)}; }
  }
}

DI void resnorm_row(const Params& p, int which, int row, const f32x4 (&gv)[4], f32x4 (&hv)[4], int lane) {
  const float* wpost = which == 0 ? p.in[9] : (which == 1 ? p.in[22] : p.in[29]);
  const float* wpre = which == 0 ? p.in[21] : p.in[28];
  bf16_t* xa = (bf16_t*)(p.ws + B_XA);
  float ss = 0.f;
#pragma unroll
  for (int e = 0; e < 4; ++e) ss += gv[e][0] * gv[e][0] + gv[e][1] * gv[e][1] + gv[e][2] * gv[e][2] + gv[e][3] * gv[e][3];
  ss = wave_sum(ss); const float rstd = rsqrtf(ss * (1.f / 1024.f) + EPS);
  float s2 = 0.f;
#pragma unroll
  for (int e = 0; e < 4; ++e) { const f32x4 wv = *(const f32x4*)(wpost + RCOL(e));
#pragma unroll
    for (int j = 0; j < 4; ++j) { hv[e][j] += gv[e][j] * rstd * wv[j]; s2 += hv[e][j] * hv[e][j]; }
    if (which == 2) *(f32x4*)(p.out + (size_t)row * D + RCOL(e)) = hv[e]; }
  if (which < 2) {
#pragma unroll
    for (int i = 0; i < 2; ++i) *(u32x4*)((bf16_t*)(p.ws + B_H) + (size_t)row * D + i * 512 + lane * 8) = pk8(hv[2 * i], hv[2 * i + 1]);
    s2 = wave_sum(s2); const float r2 = rsqrtf(s2 * (1.f / 1024.f) + EPS);
#pragma unroll
    for (int i = 0; i < 2; ++i) { const f32x4 w0 = *(const f32x4*)(wpre + RCOL(2 * i)), w1 = *(const f32x4*)(wpre + RCOL(2 * i + 1));
      *(u32x4*)(xa + (size_t)row * D + i * 512 + lane * 8) = pk8(hv[2 * i] * r2 * w0, hv[2 * i + 1] * r2 * w1); }
  }
}
DI void phase_resnorm(const Params& p, int which, int tid_) {
  int tid = tid_; asm volatile("" : "+v"(tid));
  const int G = gridDim.x, wid = tid >> 6, lane = tid & 63;
  const bf16_t* gout = (const bf16_t*)(p.ws + B_GOUT);
  const float* bp = p.in[0]; const bf16_t* hb = (const bf16_t*)(p.ws + B_H);
  const int wv = blockIdx.x * 8 + wid, nwv = G * 8;
  if (wv < TP) {
    f32x4 gv[4], hv[4];
    ld_row_bf16(gout + (size_t)wv * D, gv, lane);
    if (which == 0) ld_row_f32(bp + (size_t)wv * D, hv, lane); else ld_row_bf16(hb + (size_t)wv * D, hv, lane);
    for (int r = wv; r < TP; r += nwv) {
      const int rn = (r + nwv < TP) ? r + nwv : r;
      f32x4 gn[4], hn[4];
      ld_row_bf16(gout + (size_t)rn * D, gn, lane);
      if (which == 0) ld_row_f32(bp + (size_t)rn * D, hn, lane); else ld_row_bf16(hb + (size_t)rn * D, hn, lane);
      resnorm_row(p, which, r, gv, hv, lane);
#pragma unroll
      for (int e = 0; e < 4; ++e) { gv[e] = gn[e]; hv[e] = hn[e]; }
    }
  }
  if ((wv & 3) == 0 && (wv >> 2) < TS) {
    const int rs = wv >> 2, KP = which == 2 ? 11 : 4;
    f32x4 gv[4], hv[4];
#pragma unroll
    for (int e = 0; e < 4; ++e) { gv[e] = (f32x4){0.f, 0.f, 0.f, 0.f}; const float* pp = (const float*)(p.ws + B_PART) + (size_t)rs * 1024 + RCOL(e);
      for (int kp = 0; kp < KP; ++kp) gv[e] += *(const f32x4*)(pp + (size_t)kp * 512 * 1024); }
    if (which == 0) ld_row_f32(p.in[1] + (size_t)rs * D, hv, lane); else ld_row_bf16(hb + (size_t)(TP + rs) * D, hv, lane);
    resnorm_row(p, which, TP + rs, gv, hv, lane);
  }
}

DI void attn_prompt_item(const Params& p, int item, ldsp lds, int tid_) {
  int tid = tid_; asm volatile("" : "+v"(tid));
  const int wid = __builtin_amdgcn_readfirstlane(tid >> 6), lane = tid & 63, l31 = lane & 31, h2 = lane >> 5;
  const int b = item >> 5, h = (item >> 3) & 3, qt = item & 7;
  bf16_t* qx = (bf16_t*)(p.ws + B_QX);
  const bf16_t* mkb = (const bf16_t*)(p.ws + B_MKB);
  const bf16_t* mvt = (const bf16_t*)(p.ws + B_MVT);
  const size_t qrow = (size_t)b * 2048 + qt * 256 + wid * 32 + l31;
  bf16x8 qreg[8];
#pragma unroll
  for (int s = 0; s < 8; ++s) qreg[s] = *(const bf16x8*)(qx + qrow * D + h * 256 + 16 * s + 8 * h2);
#pragma unroll
  for (int hb = 0; hb < 2; ++hb) {
    u32x4 kp[8];
#pragma unroll
    for (int i = 0; i < 8; ++i) { const int idx = tid + 512 * (hb * 8 + i), key = idx >> 5, c = idx & 31; kp[i] = ld16(mkb + (size_t)(b * 256 + key) * D + h * 256 + c * 8); }
#pragma unroll
    for (int i = 0; i < 8; ++i) { const int idx = tid + 512 * (hb * 8 + i), key = idx >> 5, c = idx & 31; *(LAS u32x4*)(lds + key * 512 + ((c ^ (key & 15)) * 16)) = kp[i]; }
  }
  __syncthreads();
  f32x16 S[8];
#pragma unroll
  for (int kt = 0; kt < 8; ++kt)
#pragma unroll
    for (int i = 0; i < 16; ++i) S[kt][i] = 0.f;
#pragma unroll
  for (int sh = 0; sh < 2; ++sh) {
    if (sh == 1) {
      __builtin_amdgcn_sched_barrier(0);
#pragma unroll
      for (int s = 0; s < 8; ++s) qreg[s] = *(const bf16x8*)(qx + qrow * D + h * 256 + 16 * (8 + s) + 8 * h2);
    }
    {
      bf16x8 kfa[4], kfb[4];
#define KF_ADDR(gi, j) (lds + (((gi) >> 1) * 32 + l31) * 512 + (((2 * (sh * 8 + ((gi) & 1) * 4 + (j)) + h2) ^ (l31 & 15)) * 16))
#pragma unroll
      for (int j = 0; j < 4; ++j) kfa[j] = *(const LAS bf16x8*)KF_ADDR(0, j);
#pragma unroll
      for (int gi = 0; gi < 16; ++gi) {
        if (gi + 1 < 16) {
#pragma unroll
          for (int j = 0; j < 4; ++j) { if (gi & 1) kfa[j] = *(const LAS bf16x8*)KF_ADDR(gi + 1, j); else kfb[j] = *(const LAS bf16x8*)KF_ADDR(gi + 1, j); } }
#pragma unroll
        for (int j = 0; j < 4; ++j) S[gi >> 1] = __builtin_amdgcn_mfma_f32_32x32x16_bf16((gi & 1) ? kfb[j] : kfa[j], qreg[(gi & 1) * 4 + j], S[gi >> 1], 0, 0, 0);
        __builtin_amdgcn_sched_barrier(0);
      }
#undef KF_ADDR
    }
  }
  float mx = -1e30f;
#pragma unroll
  for (int kt = 0; kt < 8; ++kt)
#pragma unroll
    for (int i = 0; i < 16; ++i) mx = fmaxf(mx, S[kt][i]);
  mx = fmaxf(mx, __shfl_xor(mx, 32));
  float sum = 0.f;
#pragma unroll
  for (int kt = 0; kt < 8; ++kt)
#pragma unroll
    for (int i = 0; i < 16; ++i) { const float e = __expf(S[kt][i] - mx); S[kt][i] = e; sum += e; }
  sum += __shfl_xor(sum, 32);
  const float inv = 1.f / sum;
  bf16x8 pb[8][2];
#pragma unroll
  for (int kt = 0; kt < 8; ++kt)
#pragma unroll
    for (int s = 0; s < 2; ++s) {
      u32x4 pw; pw.x = pk2(S[kt][8 * s], S[kt][8 * s + 1]); pw.y = pk2(S[kt][8 * s + 2], S[kt][8 * s + 3]); pw.z = pk2(S[kt][8 * s + 4], S[kt][8 * s + 5]); pw.w = pk2(S[kt][8 * s + 6], S[kt][8 * s + 7]);
      pb[kt][s] = __builtin_bit_cast(bf16x8, pw);
    }
  __syncthreads();
#pragma unroll
  for (int hb = 0; hb < 2; ++hb) {
    u32x4 vp[8];
#pragma unroll
    for (int i = 0; i < 8; ++i) { const int idx = tid + 512 * (hb * 8 + i), d = idx >> 5, c = idx & 31; vp[i] = ld16(mvt + ((size_t)((b * 4 + h) * 256 + d)) * 256 + c * 8); }
#pragma unroll
    for (int i = 0; i < 8; ++i) { const int idx = tid + 512 * (hb * 8 + i), d = idx >> 5, c = idx & 31; *(LAS u32x4*)(lds + d * 512 + ((c ^ (d & 15)) * 16)) = vp[i]; }
  }
  __syncthreads();
#pragma unroll
  for (int dh = 0; dh < 2; ++dh) {
    f32x16 O[4];
#pragma unroll
    for (int dt = 0; dt < 4; ++dt)
#pragma unroll
      for (int i = 0; i < 16; ++i) O[dt][i] = 0.f;
    {
      u32x2 va[4][2], vb[4][2];
#define VF_ADDR(gi, dt, hl) (lds + ((dh * 4 + (dt)) * 32 + l31) * 512 + ((((2 * (gi)) + (hl)) ^ (l31 & 15)) * 16) + 8 * h2)
#pragma unroll
      for (int dt = 0; dt < 4; ++dt) { va[dt][0] = *(const LAS u32x2*)VF_ADDR(0, dt, 0); va[dt][1] = *(const LAS u32x2*)VF_ADDR(0, dt, 1); }
#pragma unroll
      for (int gi = 0; gi < 16; ++gi) {
        if (gi + 1 < 16) {
#pragma unroll
          for (int dt = 0; dt < 4; ++dt) {
            if (gi & 1) { va[dt][0] = *(const LAS u32x2*)VF_ADDR(gi + 1, dt, 0); va[dt][1] = *(const LAS u32x2*)VF_ADDR(gi + 1, dt, 1); }
            else { vb[dt][0] = *(const LAS u32x2*)VF_ADDR(gi + 1, dt, 0); vb[dt][1] = *(const LAS u32x2*)VF_ADDR(gi + 1, dt, 1); } } }
#pragma unroll
        for (int dt = 0; dt < 4; ++dt) { const u32x2 lo = (gi & 1) ? vb[dt][0] : va[dt][0], hi = (gi & 1) ? vb[dt][1] : va[dt][1];
          u32x4 vw; vw.x = lo.x; vw.y = lo.y; vw.z = hi.x; vw.w = hi.y;
          O[dt] = __builtin_amdgcn_mfma_f32_32x32x16_bf16(__builtin_bit_cast(bf16x8, vw), pb[gi >> 1][gi & 1], O[dt], 0, 0, 0); }
        __builtin_amdgcn_sched_barrier(0);
      }
#undef VF_ADDR
    }
#pragma unroll
    for (int dt = 0; dt < 4; ++dt)
#pragma unroll
      for (int g4 = 0; g4 < 4; ++g4) { u32x2 w; w.x = pk2(O[dt][4 * g4] * inv, O[dt][4 * g4 + 1] * inv); w.y = pk2(O[dt][4 * g4 + 2] * inv, O[dt][4 * g4 + 3] * inv);
        *(u32x2*)((bf16_t*)(p.ws + B_XA) + qrow * D + h * 256 + (dh * 4 + dt) * 32 + 8 * g4 + 4 * h2) = w; }
  }
  __syncthreads();
}

DI void attn_sample_item(const Params& p, int item, ldsp lds, int tid_) {
  int tid = tid_; asm volatile("" : "+v"(tid));
  const int wid = tid >> 6, lane = tid & 63;
  const int b = item >> 2, h = item & 3;
  bf16_t* qx = (bf16_t*)(p.ws + B_QX);
  const float* ck = p.in[6] + ((size_t)b * 256 * 4 + h) * 256;
  const float* cv = p.in[7] + ((size_t)b * 256 * 4 + h) * 256;
  LAS float* SC = (LAS float*)lds;
  LAS float* PART = (LAS float*)(lds + 4096);
  float q[4][4];
#pragma unroll
  for (int t = 0; t < 4; ++t) { f32x4 a = {0.f, 0.f, 0.f, 0.f}; const float* pp = (const float*)(p.ws + B_PART) + (size_t)(b * 4 + t) * 1024 + h * 256 + lane * 4;
#pragma unroll
    for (int kp = 0; kp < 4; ++kp) a += *(const f32x4*)(pp + (size_t)kp * 512 * 1024);
    q[t][0] = a[0] * 0.0625f; q[t][1] = a[1] * 0.0625f; q[t][2] = a[2] * 0.0625f; q[t][3] = a[3] * 0.0625f; }
  const bool b0 = lane & 1, b1 = lane & 2;
  f32x4 kvA[16], kvB[16];
#pragma unroll
  for (int j = 0; j < 16; ++j) kvA[j] = __builtin_nontemporal_load((const f32x4*)(ck + (size_t)(wid * 32 + j) * 1024 + lane * 4));
#pragma unroll
  for (int j = 0; j < 16; ++j) kvB[j] = __builtin_nontemporal_load((const f32x4*)(ck + (size_t)(wid * 32 + 16 + j) * 1024 + lane * 4));
#define SC_SCORE(KV, KB) _Pragma("unroll") for (int j = 0; j < 16; ++j) { float a[4]; \
      _Pragma("unroll") for (int t = 0; t < 4; ++t) a[t] = KV[j][0] * q[t][0] + KV[j][1] * q[t][1] + KV[j][2] * q[t][2] + KV[j][3] * q[t][3]; \
      float x0 = b0 ? a[2] : a[0], x1 = b0 ? a[3] : a[1]; const float y0 = b0 ? a[0] : a[2], y1 = b0 ? a[1] : a[3]; \
      x0 += __shfl_xor(y0, 1); x1 += __shfl_xor(y1, 1); \
      float z = b1 ? x1 : x0; const float w = b1 ? x0 : x1; \
      z += __shfl_xor(w, 2); z += __shfl_xor(z, 4); z += __shfl_xor(z, 8); z += __shfl_xor(z, 16); z += __shfl_xor(z, 32); \
      if (lane < 4) SC[((lane & 1) * 2 + (lane >> 1)) * 256 + wid * 32 + (KB) * 16 + j] = z; }
  SC_SCORE(kvA, 0)
  SC_SCORE(kvB, 1)
#undef SC_SCORE
  f32x4 vvA[16], vvB[16];
#pragma unroll
  for (int j = 0; j < 16; ++j) vvA[j] = __builtin_nontemporal_load((const f32x4*)(cv + (size_t)(wid * 32 + j) * 1024 + lane * 4));
  lbar();
  if (wid < 4) {
    float v[4]; float mx = -1e30f;
#pragma unroll
    for (int j = 0; j < 4; ++j) { v[j] = SC[wid * 256 + j * 64 + lane]; mx = fmaxf(mx, v[j]); }
    for (int o = 32; o >= 1; o >>= 1) mx = fmaxf(mx, __shfl_xor(mx, o));
    float s = 0.f;
#pragma unroll
    for (int j = 0; j < 4; ++j) { v[j] = __expf(v[j] - mx); s += v[j]; }
    s = wave_sum(s); const float inv = 1.f / s;
#pragma unroll
    for (int j = 0; j < 4; ++j) SC[wid * 256 + j * 64 + lane] = v[j] * inv;
  }
#pragma unroll
  for (int j = 0; j < 16; ++j) vvB[j] = __builtin_nontemporal_load((const f32x4*)(cv + (size_t)(wid * 32 + 16 + j) * 1024 + lane * 4));
  lbar();
  {
    f32x4 acc[4];
#pragma unroll
    for (int t = 0; t < 4; ++t) acc[t] = (f32x4){0.f, 0.f, 0.f, 0.f};
#pragma unroll
    for (int t = 0; t < 4; ++t)
#pragma unroll
      for (int j4 = 0; j4 < 4; ++j4) { const f32x4 pp = *(const LAS f32x4*)(SC + t * 256 + wid * 32 + j4 * 4);
#pragma unroll
        for (int e = 0; e < 4; ++e) acc[t] += pp[e] * vvA[j4 * 4 + e]; }
#pragma unroll
    for (int t = 0; t < 4; ++t)
#pragma unroll
      for (int j4 = 0; j4 < 4; ++j4) { const f32x4 pp = *(const LAS f32x4*)(SC + t * 256 + wid * 32 + 16 + j4 * 4);
#pragma unroll
        for (int e = 0; e < 4; ++e) acc[t] += pp[e] * vvB[j4 * 4 + e]; }
#pragma unroll
    for (int t = 0; t < 4; ++t) *(LAS f32x4*)(PART + (wid * 4 + t) * 256 + lane * 4) = acc[t];
  }
  lbar();
  {
    const int e0 = tid * 2, t = e0 >> 8, d = e0 & 255;
    float s0 = 0.f, s1 = 0.f;
#pragma unroll
    for (int w = 0; w < 8; ++w) { const f32x2 v = *(const LAS f32x2*)(PART + (w * 4 + t) * 256 + d); s0 += v[0]; s1 += v[1]; }
    *(unsigned*)((bf16_t*)(p.ws + B_XA) + (size_t)(TP + b * 4 + t) * D + h * 256 + d) = pk2(s0, s1);
  }
  lbar();
}

DI void phase_attn(const Params& p, ldsp lds, int tid) {
  const int G = gridDim.x;
  if (blockIdx.x & 1) for (int j = blockIdx.x; j < 512; j += G) attn_sample_item(p, j, lds, tid);
  for (int i = blockIdx.x; i < 256; i += G) attn_prompt_item(p, i, lds, tid);
  if (!(blockIdx.x & 1)) for (int j = blockIdx.x; j < 512; j += G) attn_sample_item(p, j, lds, tid);
}


constexpr size_t WS_BAR = WS_END;
#define XB_TMO      128
#define XB_XCNT(j)  (256  + 64 * (j))
#define XB_XSUB(j)  (1280 + 64 * (j))
#define XB_XGEN(j)  (2304 + 64 * (j))
#define XB_TOP      3328
#define XB_TOPGEN   3392
#define XCD_BAR_WORDS 3456
#define XB_SPIN_CAP (1u << 20)
DI unsigned xb_ld(unsigned* p)              { return __hip_atomic_load(p, __ATOMIC_RELAXED, __HIP_MEMORY_SCOPE_AGENT); }
DI unsigned xb_add(unsigned* p, unsigned v) { return __hip_atomic_fetch_add(p, v, __ATOMIC_RELAXED, __HIP_MEMORY_SCOPE_AGENT); }
DI unsigned xb_xcc_id() { return (unsigned)__builtin_amdgcn_s_getreg((3 << 11) | 20) & 0xFu; }
#define XB_SPIN(cond, bar) do { unsigned _sp = 0; while (cond) { __builtin_amdgcn_s_sleep(1); \
    if ((++_sp & 255u) == 0u) { if (xb_ld(&(bar)[XB_TMO])) break; if (_sp > XB_SPIN_CAP) { atomicAdd(&(bar)[XB_TMO], 1u); break; } } } } while (0)
struct XcdBarrier { unsigned* bar; unsigned x; volatile LAS unsigned* st; };
DI void xcd_barrier_complete(unsigned* bar, unsigned x, unsigned& nloc, unsigned& nx) {
  const unsigned G = gridDim.x;
  unsigned sum, cnt, mine, sp = 0u;
  for (;;) {
    sum = 0u; cnt = 0u; mine = 0u;
#pragma unroll
    for (unsigned j = 0; j < 16; ++j) { const unsigned c = xb_ld(&bar[XB_XCNT(j)]); sum += c; cnt += (c > 0u) ? 1u : 0u; mine = (j == x) ? c : mine; }
    if (sum == G) break;
    __builtin_amdgcn_s_sleep(1);
    if ((++sp & 255u) == 0u) { if (xb_ld(&bar[XB_TMO])) break; if (sp > XB_SPIN_CAP) { atomicAdd(&bar[XB_TMO], 1u); break; } }
  }
  nloc = mine > 0u ? mine : 1u; nx = cnt > 0u ? cnt : 1u;
}
DI void xcd_barrier(const XcdBarrier& b) {
  asm volatile("s_waitcnt vmcnt(0)" ::: "memory");
  __syncthreads();
  if (threadIdx.x == 0) {
    unsigned* bar = b.bar;
    __builtin_amdgcn_s_waitcnt(0);
    unsigned nloc = b.st[0], nx = b.st[1];
    if (nloc == 0u) { xcd_barrier_complete(bar, b.x, nloc, nx); b.st[0] = nloc; b.st[1] = nx; }
    const unsigned old = xb_add(&bar[XB_XSUB(b.x)], 1u);
    const unsigned gen = old / nloc;
    if (old + 1u == (gen + 1u) * nloc) {
      __builtin_amdgcn_fence(__ATOMIC_RELEASE, "agent");
      asm volatile("s_waitcnt vmcnt(0)" ::: "memory");
      __builtin_amdgcn_fence(__ATOMIC_ACQUIRE, "agent");
      const unsigned og = xb_add(&bar[XB_TOP], 1u);
      const unsigned tg = og / nx;
      if (og + 1u == (tg + 1u) * nx) xb_add(&bar[XB_TOPGEN], 1u);
      else XB_SPIN(xb_ld(&bar[XB_TOPGEN]) == tg, bar);
      xb_add(&bar[XB_XGEN(b.x)], 1u);
      asm volatile("s_waitcnt vmcnt(0)" ::: "memory");
    } else {
      __builtin_amdgcn_fence(__ATOMIC_ACQUIRE, "agent");
      XB_SPIN(xb_ld(&bar[XB_XGEN(b.x)]) == gen, bar);
      asm volatile("s_waitcnt vmcnt(0)" ::: "memory");
    }
  }
  __syncthreads();
}

__global__ void __launch_bounds__(512, 2) fwd_mega(Params p) {
  extern __shared__ __attribute__((aligned(16))) unsigned char lds_raw[];
  ldsp lds = (ldsp)lds_raw;
  cg::grid_group grid = cg::this_grid();
  const int tid = threadIdx.x, G = gridDim.x, bid = blockIdx.x;
  unsigned char* ws = p.ws;
  bf16_t* xa = (bf16_t*)(ws + B_XA);
  bf16_t* gout = (bf16_t*)(ws + B_GOUT);
  float* part = (float*)(ws + B_PART);
  unsigned* barw = (unsigned*)(ws + WS_BAR);
  __shared__ uint4 xb_words;
  if (tid == 0) xb_words = make_uint4(0u, 0u, 0u, 0u);
  XcdBarrier xbar; xbar.bar = barw; xbar.x = xb_xcc_id(); xbar.st = (volatile LAS unsigned*)&xb_words;
  if (p.ws == nullptr) grid.sync();
  if (tid == 0) (void)xb_add(&barw[XB_XCNT(xbar.x)], 1u);
  __syncthreads();

#ifndef PHMASK
#define PHMASK 0xffff
#endif
#ifndef REPMASK
#define REPMASK 0
#endif
#ifndef XSYNC
#define XSYNC 0
#endif
#define PH(n) for (int rep_ = 0; rep_ < (((PHMASK >> (n)) & 1) + ((REPMASK >> (n)) & 1)); ++rep_)
  PH(0) phase_prep(p, lds, tid);
  xcd_barrier(xbar);
  PH(1) {
    pg8::Sched S{xa, (const bf16_t*)(ws + W_IN), T / 256, NINP / 256, (const bf16_t*)(ws + B_MN), (const bf16_t*)(ws + W_KV), 8, 8, G, bid, 1024, 0, 1};
    pg8::EpiP1 E{(bf16_t*)(ws + B_PROJ), p.out + O_MK, p.out + O_MV, (bf16_t*)(ws + B_MKB), (bf16_t*)(ws + B_MVT)};
    pg8::gemm_phase(lds, S, E);
  }
  xcd_barrier(xbar);
  PH(13) phase_precompute(p, lds, tid);
  xcd_barrier(xbar);
  PH(2) phase_mixer(p, lds, tid);
  xcd_barrier(xbar);
  PH(3) phase_mixnorm(p, tid);
  xcd_barrier(xbar);
  PH(4) {
    pg8::Sched S{xa, (const bf16_t*)(ws + W_OUT), TP / 256, 4, nullptr, nullptr, 0, 0, G, bid, 1024, 2, 4};
    pg8::EpiF32 E{gout, D, part};
    pg8::gemm_phase(lds, S, E);
  }
  xcd_barrier(xbar);
  PH(5) phase_resnorm(p, 0, tid);
  xcd_barrier(xbar);
  PH(6) {
    pg8::Sched S{xa, (const bf16_t*)(ws + W_XQ), TP / 256, 4, nullptr, nullptr, 0, 0, G, bid, 1024, 2, 4};
    pg8::EpiBf16 E{(bf16_t*)(ws + B_QX), D, 0.0625f, part};
    pg8::gemm_phase(lds, S, E);
  }
  xcd_barrier(xbar);
  PH(7) phase_attn(p, lds, tid);
  xcd_barrier(xbar);
  PH(8) {
    pg8::Sched S{xa, (const bf16_t*)(ws + W_XO), TP / 256, 4, nullptr, nullptr, 0, 0, G, bid, 1024, 2, 4};
    pg8::EpiF32 E{gout, D, part};
    pg8::gemm_phase(lds, S, E);
  }
  xcd_barrier(xbar);
  PH(9) phase_resnorm(p, 1, tid);
  xcd_barrier(xbar);
  PH(10) {
    pg8::Sched S{xa, (const bf16_t*)(ws + W_GU), T / 256, 22, nullptr, nullptr, 0, 0, G, bid, 1024, 0, 1};
    pg8::EpiGU E{(bf16_t*)(ws + B_PROJ)};
    pg8::gemm_phase(lds, S, E);
  }
  xcd_barrier(xbar);
  PH(11) {
    pg8::Sched S{(const bf16_t*)(ws + B_PROJ), (const bf16_t*)(ws + W_DN), TP / 256, 4, nullptr, nullptr, 0, 0, G, bid, DFF, 2, 11};
    pg8::EpiF32 E{gout, D, part};
    pg8::gemm_phase(lds, S, E);
  }
  xcd_barrier(xbar);
  for (int xs_ = 0; xs_ < XSYNC; ++xs_) xcd_barrier(xbar);
  PH(12) phase_resnorm(p, 2, tid);
}

extern "C" void kernel_launch(void* const* d_in, const int* in_sizes, int n_in, void* d_out, int out_size, void* d_ws, size_t ws_size, hipStream_t stream) {
  static int grid_blocks = 0;
  if (!grid_blocks) {
    int dev = 0, cus = 0, per_cu = 0;
    (void)hipGetDevice(&dev);
    (void)hipDeviceGetAttribute(&cus, hipDeviceAttributeMultiprocessorCount, dev);
    (void)hipFuncSetAttribute((const void*)fwd_mega, hipFuncAttributeMaxDynamicSharedMemorySize, LDS_BYTES);
    (void)hipOccupancyMaxActiveBlocksPerMultiprocessor(&per_cu, (const void*)fwd_mega, 512, LDS_BYTES);
    if (per_cu < 1) per_cu = 1;
    grid_blocks = cus * per_cu;
    if (ws_size < WS_END + XCD_BAR_WORDS * 4) fprintf(stderr, "workspace too small: %zu < %zu\n", ws_size, (size_t)WS_END);
  }
  Params p{};
  for (int i = 0; i < 33; ++i) p.in[i] = (const float*)d_in[i];
  p.out = (float*)d_out; p.ws = (unsigned char*)d_ws;
  (void)hipMemsetAsync((unsigned char*)d_ws + WS_BAR, 0, XCD_BAR_WORDS * 4, stream);
  void* args[] = {&p};
  hipError_t e = hipLaunchCooperativeKernel((const void*)fwd_mega, dim3(grid_blocks), dim3(512), args, LDS_BYTES, stream);
  if (e != hipSuccess) fprintf(stderr, "cooperative launch failed: %s (grid %d)\n", hipGetErrorString(e), grid_blocks);
}
```
